# Optimizing an MI355X kernel written in HIP

```python
import math
import jax, jax.numpy as jnp
from jax import lax
import numpy as np

D_MODEL = 1024
BATCH = 16
SEQ = 4096
DEPTH = 4

MIX_WIDTH = D_MODEL
GMLP_GROUPS = 4
GMLP_GROUP_DIM = 128
GMLP_CHUNK = 128
GMLP_WIDTH = GMLP_GROUPS * GMLP_GROUP_DIM
GDN_HEADS = 4
GDN_HEAD_DIM = 128
GDN_WIDTH = GDN_HEADS * GDN_HEAD_DIM
GDN_CHUNK = 64
GDN_CONV = 4
DIFF_HEADS = 4
DIFF_QK_DIM = 64
DIFF_V_DIM = 2 * DIFF_QK_DIM
DIFF_WIDTH = DIFF_HEADS * DIFF_V_DIM
DSA_HEADS = 4
DSA_HEAD_DIM = 128
DSA_WIDTH = DSA_HEADS * DSA_HEAD_DIM
IDX_HEADS = 8
IDX_DIM = 64
IDX_TOPK_MAX = 256
Q_BLOCK = 128
REL_BUCKETS = 32
REL_MAX_DIST = 128
N_BIAS_HEADS = DIFF_HEADS + DSA_HEADS
D_FF = 2816
FFN_CONV = 3
EPS = 1e-6

EVEN_SIZES = (GMLP_WIDTH, GMLP_WIDTH, 3 * GDN_WIDTH, GDN_HEADS, GDN_HEADS, GDN_WIDTH)
ODD_SIZES = (DIFF_HEADS * 2 * DIFF_QK_DIM, DIFF_HEADS * 2 * DIFF_QK_DIM, DIFF_WIDTH,
             DSA_WIDTH, DSA_HEAD_DIM, DSA_HEAD_DIM, IDX_HEADS * IDX_DIM, IDX_DIM, IDX_HEADS)
EVEN_IN = sum(EVEN_SIZES)
ODD_IN = sum(ODD_SIZES)
N_EVEN = (DEPTH + 1) // 2
N_ODD = DEPTH // 2

kernel_name = 'hybrid_gmlp_gdn_diff_dsa_trunk'


def split_cols(t, sizes):
    return jnp.split(t, [int(s) for s in np.cumsum(sizes)[:-1]], axis=-1)


def rms_norm(x, g=None):
    xf = x.astype(jnp.float32)
    y = xf * lax.rsqrt(jnp.mean(xf * xf, axis=-1, keepdims=True) + EPS)
    if g is not None:
        y = y * g.astype(jnp.float32)
    return y.astype(x.dtype)


def layer_norm_plain(x):
    xf = x.astype(jnp.float32)
    xc = xf - jnp.mean(xf, axis=-1, keepdims=True)
    return (xc * lax.rsqrt(jnp.mean(xc * xc, axis=-1, keepdims=True) + EPS)).astype(x.dtype)


def l2_normalize(x):
    return x * lax.rsqrt(jnp.sum(x * x, axis=-1, keepdims=True) + EPS)


def causal_depthwise_conv(x, w):
    width, L = w.shape[0], x.shape[1]
    xp = jnp.pad(x, ((0, 0), (width - 1, 0), (0, 0)))
    out = xp[:, 0:L] * w[0]
    for j in range(1, width):
        out = out + xp[:, j:j + L] * w[j]
    return out


def rel_bucket(dist):
    exact = REL_BUCKETS // 2
    n = jnp.maximum(dist, 0)
    nf = jnp.maximum(n, exact).astype(jnp.float32)
    far = exact + (jnp.log(nf / exact) / math.log(REL_MAX_DIST / exact) * (REL_BUCKETS - exact)).astype(jnp.int32)
    return jnp.where(n < exact, n, jnp.minimum(far, REL_BUCKETS - 1))


def chunked_gmlp(u, v, w_s, b_s):
    B, L, _ = u.shape
    n = L // GMLP_CHUNK
    shp = (B, n, GMLP_CHUNK, GMLP_GROUPS, GMLP_GROUP_DIM)
    v = layer_norm_plain(v.reshape(shp))
    causal = jnp.tril(jnp.ones((GMLP_CHUNK, GMLP_CHUNK), dtype=bool))
    w = jnp.where(causal[None], w_s, 0.0)
    mixed = jnp.einsum('gts,bnsgc->bntgc', w, v) + b_s.T[None, None, :, :, None]
    return (u.reshape(shp) * mixed).reshape(B, L, GMLP_WIDTH)


def gated_delta_rule(q, k, v, beta, g):
    B, L, H, dk = q.shape
    dv = v.shape[-1]
    C = GDN_CHUNK
    n = L // C
    q = l2_normalize(q) * (dk ** -0.5)
    k = l2_normalize(k)

    def chunks(t):
        return jnp.moveaxis(t.reshape((B, n, C, H) + t.shape[3:]), 3, 1)

    q, k, v, beta, g = chunks(q), chunks(k), chunks(v), chunks(beta), chunks(g)
    g = jnp.cumsum(g, axis=-1)
    k_beta = k * beta[..., None]
    v_beta = v * beta[..., None]
    incl = jnp.tril(jnp.ones((C, C), dtype=bool))
    strict = jnp.tril(jnp.ones((C, C), dtype=bool), -1)
    decay = jnp.exp(jnp.where(incl, g[..., :, None] - g[..., None, :], -jnp.inf))
    lower = jnp.where(strict, jnp.einsum('bhnid,bhnjd->bhnij', k_beta, k) * decay, 0.0)
    eye = jnp.eye(C, dtype=q.dtype)
    t_inv = lax.linalg.triangular_solve(lower + eye, jnp.broadcast_to(eye, lower.shape),
                                        left_side=True, lower=True, unit_diagonal=True)
    u = t_inv @ v_beta
    w = t_inv @ (k_beta * jnp.exp(g)[..., None])
    intra = jnp.where(incl, jnp.einsum('bhnid,bhnjd->bhnij', q, k) * decay, 0.0)

    def step(state, inp):
        q_c, k_c, u_c, w_c, g_c, a_c = inp
        v_new = u_c - w_c @ state
        out = (q_c * jnp.exp(g_c)[..., None]) @ state + a_c @ v_new
        g_last = g_c[..., -1:]
        state = state * jnp.exp(g_last)[..., None] + jnp.einsum(
            'bhck,bhcv->bhkv', k_c * jnp.exp(g_last - g_c)[..., None], v_new)
        return state, out

    xs = tuple(jnp.moveaxis(t, 2, 0) for t in (q, k, u, w, g, intra))
    state0 = jnp.zeros((B, H, dk, dv), q.dtype)
    _, out = lax.scan(step, state0, xs)
    return jnp.transpose(out, (1, 0, 3, 2, 4)).reshape(B, L, H, dv)


def even_mixer(h, w_in, w_out, w_s, b_s, conv_w, a_log, dt_bias, out_norm_g):
    B, L, _ = h.shape
    u, v, qkv, b_raw, a_raw, z = split_cols(h @ w_in, EVEN_SIZES)
    y_a = chunked_gmlp(jax.nn.gelu(u), jax.nn.gelu(v), w_s, b_s)
    qkv = jax.nn.silu(causal_depthwise_conv(qkv, conv_w))
    q, k, vv = [t.reshape(B, L, GDN_HEADS, GDN_HEAD_DIM).astype(jnp.float32) for t in jnp.split(qkv, 3, axis=-1)]
    beta = jax.nn.sigmoid(b_raw.astype(jnp.float32))
    g = -jnp.exp(a_log.astype(jnp.float32)) * jax.nn.softplus(a_raw.astype(jnp.float32) + dt_bias.astype(jnp.float32))
    o = gated_delta_rule(q, k, vv, beta, g).astype(h.dtype)
    o = rms_norm(o, out_norm_g) * jax.nn.silu(z.reshape(B, L, GDN_HEADS, GDN_HEAD_DIM))
    y = jnp.concatenate([y_a, o.reshape(B, L, GDN_WIDTH)], axis=-1)
    return y @ w_out


def diff_attention(q, k, v, lam, bias_tab, sub_g, lambda_init):
    B, L, H, _, d = q.shape
    nb = L // Q_BLOCK
    k_pos = jnp.arange(L, dtype=jnp.int32)
    q_blocks = jnp.moveaxis(q.reshape(B, nb, Q_BLOCK, H, 2, d), 1, 0)

    def one_block(args):
        q_blk, blk = args
        q_pos = blk * Q_BLOCK + jnp.arange(Q_BLOCK, dtype=jnp.int32)
        dist = q_pos[:, None] - k_pos[None, :]
        bias = jnp.moveaxis(bias_tab[rel_bucket(dist)], -1, 0).astype(jnp.float32)
        logits = jnp.einsum('bqhmd,bkhmd->bhmqk', q_blk, k).astype(jnp.float32) * (d ** -0.5) + bias[None, :, None]
        logits = jnp.where(dist >= 0, logits, -jnp.inf)
        probs = jax.nn.softmax(logits, axis=-1)
        weights = probs[:, :, 0] - lam * probs[:, :, 1]
        return jnp.einsum('bhqk,bkhe->bqhe', weights.astype(v.dtype), v)

    out = lax.map(one_block, (q_blocks, jnp.arange(nb, dtype=jnp.int32)))
    out = jnp.moveaxis(out, 0, 1).reshape(B, L, H, v.shape[-1])
    return rms_norm(out, sub_g) * (1.0 - lambda_init)


def dsa_attention(q, k, v, q_idx, k_idx, w_idx, bias_tab):
    B, L, H, d = q.shape
    nb = L // Q_BLOCK
    top_k = min(IDX_TOPK_MAX, L // 4)
    k_pos = jnp.arange(L, dtype=jnp.int32)
    gather = jax.vmap(lambda t, i: t[i])

    def blocks(t):
        return jnp.moveaxis(t.reshape((B, nb, Q_BLOCK) + t.shape[2:]), 1, 0)

    def one_block(args):
        q_blk, qi_blk, wi_blk, blk = args
        q_pos = blk * Q_BLOCK + jnp.arange(Q_BLOCK, dtype=jnp.int32)
        s = jnp.einsum('bqhd,bkd->bqhk', qi_blk, k_idx).astype(jnp.float32) * (IDX_DIM ** -0.5)
        index = jnp.einsum('bqh,bqhk->bqk', wi_blk.astype(jnp.float32), jax.nn.relu(s))
        index = jnp.where(k_pos[None, :] <= q_pos[:, None], index, -jnp.inf)
        _, sel = lax.top_k(index, top_k)
        valid = sel <= q_pos[None, :, None]
        k_sel = gather(k, sel)
        v_sel = gather(v, sel)
        bias = jnp.moveaxis(bias_tab[rel_bucket(q_pos[None, :, None] - sel)], -1, 1).astype(jnp.float32)
        logits = jnp.einsum('bqhd,bqkd->bhqk', q_blk, k_sel).astype(jnp.float32) * (d ** -0.5) + bias
        logits = jnp.where(valid[:, None], logits, -jnp.inf)
        probs = jax.nn.softmax(logits, axis=-1)
        return jnp.einsum('bhqk,bqkd->bqhd', probs.astype(v.dtype), v_sel)

    out = lax.map(one_block, (blocks(q), blocks(q_idx), blocks(w_idx), jnp.arange(nb, dtype=jnp.int32)))
    return jnp.moveaxis(out, 0, 1).reshape(B, L, H * d)


def odd_mixer(h, w_in, w_out, diff_q_g, diff_k_g, diff_lam, diff_sub_g, dsa_q_g, dsa_k_g, rel_bias, lambda_init):
    B, L, _ = h.shape
    dq, dk, dv, sq, sk, sv, iq, ik, iw = split_cols(h @ w_in, ODD_SIZES)
    dq = rms_norm(dq.reshape(B, L, DIFF_HEADS, 2, DIFF_QK_DIM), diff_q_g)
    dk = rms_norm(dk.reshape(B, L, DIFF_HEADS, 2, DIFF_QK_DIM), diff_k_g)
    dv = dv.reshape(B, L, DIFF_HEADS, DIFF_V_DIM)
    lf = diff_lam.astype(jnp.float32)
    lam = jnp.exp(jnp.sum(lf[0] * lf[1])) - jnp.exp(jnp.sum(lf[2] * lf[3])) + lambda_init
    y_c = diff_attention(dq, dk, dv, lam, rel_bias[:, :DIFF_HEADS], diff_sub_g, lambda_init).reshape(B, L, DIFF_WIDTH)
    sq = rms_norm(sq.reshape(B, L, DSA_HEADS, DSA_HEAD_DIM), dsa_q_g)
    sk = rms_norm(sk, dsa_k_g)
    iq = iq.reshape(B, L, IDX_HEADS, IDX_DIM)
    iw = iw * (IDX_HEADS ** -0.5)
    y_d = dsa_attention(sq, sk, sv, iq, ik, iw, rel_bias[:, DIFF_HEADS:])
    y = jnp.concatenate([y_c, y_d], axis=-1)
    return y @ w_out


def conv_ffn(h, w_up, conv_w, conv_b, w_down):
    up = causal_depthwise_conv(h @ w_up, conv_w) + conv_b
    gate, val = jnp.split(up, 2, axis=-1)
    return (jax.nn.silu(gate) * val) @ w_down


def setup_inputs(seed: int = 0) -> dict:
    key = jax.random.key(seed)
    ks = iter(jax.random.split(key, 32))

    def nrm(shape, scale):
        return jax.random.normal(next(ks), shape, jnp.float32) * scale

    def gain(shape):
        return 1.0 + nrm(shape, 0.02)

    out_scale = (2 * DEPTH) ** -0.5
    dt = jnp.exp(jax.random.uniform(next(ks), (N_EVEN, GDN_HEADS), jnp.float32, math.log(1e-3), math.log(1e-1)))
    a_init = jax.random.uniform(next(ks), (N_EVEN, GDN_HEADS), jnp.float32, 1.0, 16.0)
    return {
        'x': nrm((BATCH, SEQ, D_MODEL), 1.0),
        'rel_bias': nrm((REL_BUCKETS, N_BIAS_HEADS), 0.5),
        'mix_norm_g': gain((DEPTH, D_MODEL)),
        'ev_w_in': nrm((N_EVEN, D_MODEL, EVEN_IN), D_MODEL ** -0.5),
        'ev_w_out': nrm((N_EVEN, MIX_WIDTH, D_MODEL), MIX_WIDTH ** -0.5 * out_scale),
        'gmlp_w_s': nrm((N_EVEN, GMLP_GROUPS, GMLP_CHUNK, GMLP_CHUNK), GMLP_CHUNK ** -0.5),
        'gmlp_b_s': 1.0 + nrm((N_EVEN, GMLP_GROUPS, GMLP_CHUNK), 0.1),
        'gdn_conv_w': nrm((N_EVEN, GDN_CONV, 3 * GDN_WIDTH), GDN_CONV ** -0.5),
        'gdn_a_log': jnp.log(a_init),
        'gdn_dt_bias': dt + jnp.log(-jnp.expm1(-dt)),
        'gdn_norm_g': gain((N_EVEN, GDN_HEAD_DIM)),
        'od_w_in': nrm((N_ODD, D_MODEL, ODD_IN), D_MODEL ** -0.5),
        'od_w_out': nrm((N_ODD, MIX_WIDTH, D_MODEL), MIX_WIDTH ** -0.5 * out_scale),
        'diff_q_norm_g': gain((N_ODD, DIFF_QK_DIM)),
        'diff_k_norm_g': gain((N_ODD, DIFF_QK_DIM)),
        'diff_lambda': nrm((N_ODD, 4, DIFF_QK_DIM), 0.1),
        'diff_sub_norm_g': gain((N_ODD, DIFF_V_DIM)),
        'dsa_q_norm_g': gain((N_ODD, DSA_HEAD_DIM)),
        'dsa_k_norm_g': gain((N_ODD, DSA_HEAD_DIM)),
        'ffn_norm_g': gain((DEPTH, D_MODEL)),
        'ffn_w_up': nrm((DEPTH, D_MODEL, 2 * D_FF), D_MODEL ** -0.5),
        'ffn_conv_w': nrm((DEPTH, FFN_CONV, 2 * D_FF), FFN_CONV ** -0.5),
        'ffn_conv_b': nrm((DEPTH, 2 * D_FF), 0.01),
        'ffn_w_down': nrm((DEPTH, D_FF, D_MODEL), D_FF ** -0.5 * out_scale),
    }


def reference(x, rel_bias, mix_norm_g, ev_w_in, ev_w_out, gmlp_w_s, gmlp_b_s, gdn_conv_w, gdn_a_log,
              gdn_dt_bias, gdn_norm_g, od_w_in, od_w_out, diff_q_norm_g, diff_k_norm_g, diff_lambda,
              diff_sub_norm_g, dsa_q_norm_g, dsa_k_norm_g, ffn_norm_g, ffn_w_up, ffn_conv_w, ffn_conv_b,
              ffn_w_down):
    h = x
    for layer in range(DEPTH):
        j = layer // 2
        hn = rms_norm(h, mix_norm_g[layer])
        if layer % 2 == 0:
            h = h + even_mixer(hn, ev_w_in[j], ev_w_out[j], gmlp_w_s[j], gmlp_b_s[j], gdn_conv_w[j],
                               gdn_a_log[j], gdn_dt_bias[j], gdn_norm_g[j])
        else:
            lambda_init = 0.8 - 0.6 * math.exp(-0.3 * layer)
            h = h + odd_mixer(hn, od_w_in[j], od_w_out[j], diff_q_norm_g[j], diff_k_norm_g[j], diff_lambda[j],
                              diff_sub_norm_g[j], dsa_q_norm_g[j], dsa_k_norm_g[j], rel_bias, lambda_init)
        h = h + conv_ffn(rms_norm(h, ffn_norm_g[layer]), ffn_w_up[layer], ffn_conv_w[layer],
                         ffn_conv_b[layer], ffn_w_down[layer])
    return h
```

```cpp
#include <hip/hip_runtime.h>
#include <hip/hip_cooperative_groups.h>
#include <cstdio>
namespace cg = cooperative_groups;

#define LAS __attribute__((address_space(3)))
typedef _Float16 h16;
typedef _Float16 h16x2 __attribute__((ext_vector_type(2)));
typedef _Float16 h16x4 __attribute__((ext_vector_type(4)));
typedef _Float16 h16x8 __attribute__((ext_vector_type(8)));
typedef float f32x2 __attribute__((ext_vector_type(2)));
typedef float f32x4 __attribute__((ext_vector_type(4)));
typedef float f32x16 __attribute__((ext_vector_type(16)));
typedef unsigned u32x4 __attribute__((ext_vector_type(4)));
typedef unsigned u32x2 __attribute__((ext_vector_type(2)));

constexpr int T = 65536, D = 1024, SEQ = 4096, NBATCH = 16, DEPTH = 4;
constexpr int EV_N = 3328, EV_SRC = 3080, OD_N = 3072, OD_SRC = 2888, FF = 2816, FF2 = 5632;
constexpr float EPS = 1e-6f;
constexpr int NTHREADS = 512;
constexpr int LDS_BYTES = 147456;

constexpr size_t SZ_WIN_E = (size_t)EV_N * D * 2, SZ_WIN_O = (size_t)OD_N * D * 2, SZ_WOUT = (size_t)D * D * 2, SZ_WUP = (size_t)FF2 * D * 2, SZ_WDN = (size_t)D * FF * 2;
constexpr size_t WS_WIN_E = 0;
constexpr size_t WS_WIN_O = WS_WIN_E + 2 * SZ_WIN_E;
constexpr size_t WS_WOUT = WS_WIN_O + 2 * SZ_WIN_O;
constexpr size_t WS_WUP = WS_WOUT + 4 * SZ_WOUT;
constexpr size_t WS_WDN = WS_WUP + 4 * SZ_WUP;
constexpr size_t WS_HB = WS_WDN + 4 * SZ_WDN;
constexpr size_t WS_RSQ = WS_HB + (size_t)T * D * 2;
constexpr size_t WS_BA = WS_RSQ + (size_t)9 * T * 4;
constexpr size_t WS_GWS = WS_BA + (size_t)T * 8 * 4;
constexpr size_t WS_BIASD = WS_GWS + (size_t)2 * 4 * 128 * 128 * 2;
constexpr size_t WS_MISC = WS_BIASD + 8 * 132 * 4;
constexpr size_t WS_GCL = WS_MISC + 256;
constexpr size_t WS_GTAB = WS_GCL + (size_t)(T / 64) * 4 * 4;
constexpr size_t WS_HALO = WS_GTAB + 2 * 4 * 128 * 4;
constexpr size_t WS_R = WS_HALO + (size_t)(T / 64) * 2 * FF2 * 2;
constexpr size_t R_PROJ = 0;
constexpr size_t R_Y = (size_t)T * EV_N * 2;
constexpr size_t R_G = R_Y + (size_t)T * D * 2;
constexpr size_t R_QG = R_G, R_KDT = R_G + (size_t)T * 512 * 2, R_INTRA = R_KDT + (size_t)T * 512 * 2;
constexpr size_t R_END = (size_t)T * FF2 * 2;
constexpr size_t WS_END = WS_R + R_END;

struct Params {
    const float* in[24];
    float* out;
    unsigned char* ws;
    int ph_lo, ph_hi;
};

typedef const __attribute__((address_space(4))) Params CParams;
__device__ __forceinline__ CParams* launder_kp() { CParams* q = (CParams*)__builtin_amdgcn_kernarg_segment_ptr(); asm volatile("" : "+s"(q)); return q; }

__device__ __forceinline__ int opaque_bid() { int b = blockIdx.x; asm volatile("" : "+v"(b)); return __builtin_amdgcn_readfirstlane(b); }

__device__ __forceinline__ int hw_lane() { unsigned m = ~0u; asm volatile("" : "+s"(m)); return (int)__builtin_amdgcn_mbcnt_hi(m, __builtin_amdgcn_mbcnt_lo(m, 0u)); }
#define TIDX (wid_s * 64 + hw_lane())

__device__ __forceinline__ float wave_sum(float v) {
#pragma unroll
    for (int o = 32; o > 0; o >>= 1) v += __shfl_xor(v, o);
    return v;
}
__device__ __forceinline__ float gelu_tanh(float x) { const float z = 1.5957691216f * (x + 0.044715f * x * x * x); return x * __builtin_amdgcn_rcpf(1.f + __expf(-z)); }
__device__ __forceinline__ float silu_f(float x) { return x * __builtin_amdgcn_rcpf(1.f + __expf(-x)); }
__device__ __forceinline__ u32x4 pack8(const f32x4 a, const f32x4 b) {
    h16x8 h; h[0] = (h16)a[0]; h[1] = (h16)a[1]; h[2] = (h16)a[2]; h[3] = (h16)a[3]; h[4] = (h16)b[0]; h[5] = (h16)b[1]; h[6] = (h16)b[2]; h[7] = (h16)b[3];
    return __builtin_bit_cast(u32x4, h);
}

namespace pg8 {
constexpr int BM = 256, BK = 64, HALF = 128, HTB = HALF * BK * 2, STAGE_BYTES = 8 * HTB, NXCD = 8, WGM = 8;
__device__ __forceinline__ int lds_byte(int r, int c) { const int st = (r >> 4) * 2 + (c >> 5), rr = r & 15, cc = c & 31, ob = rr * 64 + cc * 2; return st * 1024 + (ob ^ (((ob >> 9) & 1) << 5)); }
__device__ __forceinline__ void stage_rc(int b, int& R, int& C) { const int st = b / 1024, sb = b % 1024, swz = sb ^ (((sb >> 9) & 1) << 5); R = (st >> 1) * 16 + swz / 64; C = (st & 1) * 32 + (swz % 64) / 2; }
__device__ __forceinline__ int perm32(int rho) { const int n = rho >> 4, i = rho & 15; return 8 * (i >> 2) + 4 * n + (i & 3); }
struct Unit { int pm, pn; };
struct Gemm { const h16* A; const h16* Bt; int M, N, K, lda; };
struct StaticOrder {
    int nM, nN, nwg, G, c;
    __device__ void init(int M, int N, int G_, int c_) { nM = M / BM; nN = N / BM; nwg = nM * nN; G = G_; c = c_; }
    __device__ bool next(int i, Unit& u) const {
        const long L = (long)i * G + c; if (L >= nwg) return false;
        int wgid = (int)L; { const int q = nwg / NXCD, r = nwg % NXCD, xcd = wgid % NXCD, off = wgid / NXCD; wgid = (xcd < r ? xcd * (q + 1) : r * (q + 1) + (xcd - r) * q) + off; }
        const int nig = WGM * nN, gid = wgid / nig, fm = gid * WGM, gsz = (nM - fm) < WGM ? (nM - fm) : WGM;
        u.pm = fm + ((wgid % nig) % gsz); u.pn = (wgid % nig) / gsz; return true;
    }
};

template <class Epi>
__device__ __forceinline__ void gemm_phase(LAS unsigned char* lds, const Gemm g, const StaticOrder& S, const Epi& E, const int wid_s) {
    int tid_ = TIDX; asm volatile("" : "+v"(tid_));
    const int tid = tid_, wid = __builtin_amdgcn_readfirstlane(tid >> 6), lane = tid & 63, wr = wid >> 2, wc = wid & 3, fr = lane & 15, fq = lane >> 4;
    const int K = g.K, nt = K / BK, lda = g.lda;
    unsigned voffA[2], voffB[2];
#pragma unroll
    for (int i = 0; i < 2; ++i) { int R, C; stage_rc(tid * 16 + i * 8192, R, C); const int Rb = Epi::PERM ? ((R & ~31) + perm32(R & 31)) : R;
        voffA[i] = (unsigned)(R * lda + C) * 2u; voffB[i] = (unsigned)(Rb * K + C) * 2u; }
    const size_t kstep = (size_t)(BK * 2);
    const size_t hstepA = (size_t)HALF * lda * 2, hstepB = (size_t)HALF * K * 2;
    const size_t tstepA = 2 * hstepA, tstepB = 2 * hstepB;
    const unsigned ldsw = (unsigned)wid * 1024u;
    const int aoff = lds_byte(wr * 64 + fr, fq * 8), boff = lds_byte(wc * 32 + fr, fq * 8);
#define PG8_SA(b, h) (((b) * 2 + (h)) * HTB)
#define PG8_SB(b, h) ((4 + (b) * 2 + (h)) * HTB)
#define PG8_STAGE(bufoff, gbase, voff) do { _Pragma("unroll") for (int _i = 0; _i < 2; ++_i) \
        __builtin_amdgcn_global_load_lds((const unsigned*)((const char*)(gbase) + (voff)[_i]), (LAS unsigned*)(lds + (bufoff) + ldsw + _i * 8192), 16, 0, 0); } while (0)
#define PG8_LDA(dst, b, h) do { _Pragma("unroll") for (int m = 0; m < 4; ++m) _Pragma("unroll") for (int k = 0; k < 2; ++k) dst[m][k] = *(const LAS h16x8*)(lds + PG8_SA(b, h) + aoff + m * 2048 + k * 1024); } while (0)
#define PG8_LDB(dst, b, h) do { _Pragma("unroll") for (int n = 0; n < 2; ++n) _Pragma("unroll") for (int k = 0; k < 2; ++k) dst[n][k] = *(const LAS h16x8*)(lds + PG8_SB(b, h) + boff + n * 2048 + k * 1024); } while (0)
#define PG8_MMA(ai, bj, At, Bt) do { __builtin_amdgcn_s_setprio(1); _Pragma("unroll") for (int m = 0; m < 4; ++m) _Pragma("unroll") for (int n = 0; n < 2; ++n) _Pragma("unroll") for (int k = 0; k < 2; ++k) \
        acc[ai][bj][m][n] = __builtin_amdgcn_mfma_f32_16x16x32_f16(Bt[n][k], At[m][k], acc[ai][bj][m][n], 0, 0, 0); __builtin_amdgcn_s_setprio(0); } while (0)
#define PG8_WAIT_V(n) asm volatile("s_waitcnt vmcnt(" #n ")" ::: "memory")
#define PG8_WAIT_L(n) asm volatile("s_waitcnt lgkmcnt(" #n ")" ::: "memory")
#define PG8_BAR __builtin_amdgcn_s_barrier()
#define PG8_SCHED __builtin_amdgcn_sched_barrier(0)
    Unit cur, nxt; int ui = 0;
    if (!S.next(0, cur)) return;
    f32x4 acc[2][2][4][2];
#pragma unroll
    for (int a = 0; a < 2; ++a)
#pragma unroll
        for (int b = 0; b < 2; ++b)
#pragma unroll
            for (int m = 0; m < 4; ++m)
#pragma unroll
                for (int n = 0; n < 2; ++n) acc[a][b][m][n] = (f32x4){0.f, 0.f, 0.f, 0.f};
    h16x8 At[4][2], B0[2][2], B1[2][2];
    const char* cA = (const char*)g.A + (size_t)cur.pm * tstepA; const char* cB = (const char*)g.Bt + (size_t)cur.pn * tstepB;
    PG8_STAGE(PG8_SB(0, 0), cB, voffB); PG8_STAGE(PG8_SA(0, 0), cA, voffA); PG8_STAGE(PG8_SB(0, 1), cB + hstepB, voffB); PG8_STAGE(PG8_SA(0, 1), cA + hstepA, voffA);
    if (wr == 1) PG8_BAR;
    PG8_WAIT_V(4); PG8_BAR;
    PG8_STAGE(PG8_SB(1, 0), cB + kstep, voffB); PG8_STAGE(PG8_SA(1, 0), cA + kstep, voffA); PG8_STAGE(PG8_SB(1, 1), cB + hstepB + kstep, voffB);
    PG8_WAIT_V(6); PG8_BAR;
    for (;;) {
        const bool has_next = S.next(ui + 1, nxt);
        const char* nA = has_next ? (const char*)g.A + (size_t)nxt.pm * tstepA : cA; const char* nB = has_next ? (const char*)g.Bt + (size_t)nxt.pn * tstepB : cB;
        for (int t = 0; t < nt; t += 2) {
            const bool last = (t == nt - 2);
            const char* a1 = cA + (size_t)(t + 1) * kstep;
            const char* a2 = last ? nA : cA + (size_t)(t + 2) * kstep; const char* b2 = last ? nB : cB + (size_t)(t + 2) * kstep;
            const char* a3 = a2 + kstep; const char* b3 = b2 + kstep;
            PG8_LDB(B0, 0, 0); PG8_SCHED; PG8_LDA(At, 0, 0); PG8_STAGE(PG8_SA(1, 1), a1 + hstepA, voffA);
            PG8_WAIT_L(8); PG8_BAR; PG8_WAIT_L(0); PG8_MMA(0, 0, At, B0); PG8_BAR; PG8_SCHED;
            PG8_LDB(B1, 0, 1); PG8_STAGE(PG8_SB(0, 0), b2, voffB);
            PG8_BAR; PG8_WAIT_L(0); PG8_MMA(0, 1, At, B1); PG8_BAR;
            PG8_LDA(At, 0, 1); PG8_STAGE(PG8_SA(0, 0), a2, voffA);
            PG8_BAR; PG8_WAIT_L(0); PG8_MMA(1, 0, At, B0); PG8_BAR; PG8_SCHED;
            PG8_STAGE(PG8_SB(0, 1), b2 + hstepB, voffB);
            PG8_WAIT_V(6); PG8_BAR; PG8_MMA(1, 1, At, B1); PG8_BAR;
            PG8_LDB(B0, 1, 0); PG8_SCHED; PG8_LDA(At, 1, 0); PG8_STAGE(PG8_SA(0, 1), a2 + hstepA, voffA);
            PG8_WAIT_L(8); PG8_BAR; PG8_WAIT_L(0); PG8_MMA(0, 0, At, B0); PG8_BAR; PG8_SCHED;
            PG8_LDB(B1, 1, 1); PG8_STAGE(PG8_SB(1, 0), b3, voffB);
            PG8_BAR; PG8_WAIT_L(0); PG8_MMA(0, 1, At, B1); PG8_BAR;
            PG8_LDA(At, 1, 1); PG8_STAGE(PG8_SA(1, 0), a3, voffA);
            PG8_BAR; PG8_WAIT_L(0); PG8_MMA(1, 0, At, B0); PG8_BAR; PG8_SCHED;
            PG8_STAGE(PG8_SB(1, 1), b3 + hstepB, voffB);
            PG8_WAIT_V(6); PG8_BAR; PG8_MMA(1, 1, At, B1); PG8_BAR;
        }
        E(acc, cur, wr, wc, fr, fq);
        if (!has_next) break;
#pragma unroll
        for (int a = 0; a < 2; ++a)
#pragma unroll
            for (int b = 0; b < 2; ++b)
#pragma unroll
                for (int m = 0; m < 4; ++m)
#pragma unroll
                    for (int n = 0; n < 2; ++n) acc[a][b][m][n] = (f32x4){0.f, 0.f, 0.f, 0.f};
        cur = nxt; cA = nA; cB = nB; ++ui;
    }
    PG8_WAIT_V(0);
    if (wr == 0) PG8_BAR;
    PG8_BAR;
#undef PG8_SA
#undef PG8_SB
#undef PG8_STAGE
#undef PG8_LDA
#undef PG8_LDB
#undef PG8_MMA
#undef PG8_WAIT_V
#undef PG8_WAIT_L
#undef PG8_BAR
#undef PG8_SCHED
}

struct EpiStoreH {
    static constexpr bool PERM = true;
    h16* O; int ldc; const float* rowsq; int gelu_tiles; int ba_tile; float* ba; h16* halo;
    __device__ __forceinline__ void operator()(const f32x4 (&acc)[2][2][4][2], const Unit& u, int wr, int wc, int fr, int fq) const {
        const int row0 = u.pm * BM + wr * 64 + fr, col0 = u.pn * BM + wc * 32 + 8 * fq;
        const bool dg = u.pn < gelu_tiles, isba = (u.pn == ba_tile);
        float rsv[2][4];
#pragma unroll
        for (int ai = 0; ai < 2; ++ai)
#pragma unroll
            for (int m = 0; m < 4; ++m) rsv[ai][m] = rowsq[row0 + ai * HALF + m * 16];
#pragma unroll
        for (int ai = 0; ai < 2; ++ai)
#pragma unroll
            for (int m = 0; m < 4; ++m) {
                const int r = row0 + ai * HALF + m * 16;
                const float rs = rsqrtf(rsv[ai][m] * (1.0f / 1024.0f) + EPS);
#pragma unroll
                for (int bj = 0; bj < 2; ++bj) {
                    f32x4 v0 = acc[ai][bj][m][0] * rs, v1 = acc[ai][bj][m][1] * rs;
                    if (isba) {
                        if (bj == 0 && wc == 0 && fq == 0) { *(f32x4*)(ba + (size_t)r * 8) = v0; *(f32x4*)(ba + (size_t)r * 8 + 4) = v1; }
                    } else {
                        if (dg) {
#pragma unroll
                            for (int j = 0; j < 4; ++j) { v0[j] = gelu_tanh(v0[j]); v1[j] = gelu_tanh(v1[j]); }
                        }
                        const u32x4 w = pack8(v0, v1);
                        *(u32x4*)(O + (size_t)r * ldc + col0 + bj * HALF) = w;
                        if (halo != nullptr && m == 3 && fr >= 14) *(u32x4*)(halo + ((size_t)(r >> 6) * 2 + (fr - 14)) * ldc + col0 + bj * HALF) = w;
                    }
                }
            }
    }
};
struct EpiResid {
    static constexpr bool PERM = false;
    float* H; h16* HB; float* rsq_next;
    __device__ __forceinline__ void operator()(const f32x4 (&acc)[2][2][4][2], const Unit& u, int wr, int wc, int fr, int fq) const {
        const int row0 = u.pm * BM + wr * 64 + fr, col0 = u.pn * BM + wc * 32 + 4 * fq;
        f32x4 hin[2][2], hnx[2][2];
#pragma unroll
        for (int bj = 0; bj < 2; ++bj)
#pragma unroll
            for (int n = 0; n < 2; ++n) hin[bj][n] = *(const f32x4*)(H + (size_t)row0 * D + col0 + bj * HALF + n * 16);
#pragma unroll
        for (int g = 0; g < 8; ++g) {
            const int ai = g >> 2, m = g & 3;
            const int r = row0 + ai * HALF + m * 16; float ss = 0.f;
            if (g < 7) { const int rn = row0 + ((g + 1) >> 2) * HALF + ((g + 1) & 3) * 16;
#pragma unroll
                for (int bj = 0; bj < 2; ++bj)
#pragma unroll
                    for (int n = 0; n < 2; ++n) hnx[bj][n] = *(const f32x4*)(H + (size_t)rn * D + col0 + bj * HALF + n * 16); }
#pragma unroll
            for (int bj = 0; bj < 2; ++bj)
#pragma unroll
                for (int n = 0; n < 2; ++n) {
                    const size_t o = (size_t)r * D + col0 + bj * HALF + n * 16;
                    f32x4 hv = hin[bj][n]; hv += acc[ai][bj][m][n]; *(f32x4*)(H + o) = hv;
                    ss += hv[0] * hv[0] + hv[1] * hv[1] + hv[2] * hv[2] + hv[3] * hv[3];
                    h16x4 hh; hh[0] = (h16)hv[0]; hh[1] = (h16)hv[1]; hh[2] = (h16)hv[2]; hh[3] = (h16)hv[3];
                    *(h16x4*)(HB + o) = hh;
                }
            ss += __shfl_xor(ss, 16); ss += __shfl_xor(ss, 32);
            if (fq == 0) atomicAdd(rsq_next + r, ss);
#pragma unroll
            for (int bj = 0; bj < 2; ++bj)
#pragma unroll
                for (int n = 0; n < 2; ++n) hin[bj][n] = hnx[bj][n];
        }
    }
};

template <int CTRL> __device__ __forceinline__ float dppmov(const float oldv, const float src) {
    return __builtin_bit_cast(float, __builtin_amdgcn_update_dpp(__builtin_bit_cast(int, oldv), __builtin_bit_cast(int, src), CTRL, 0xf, 0xf, false)); }
struct EpiUpFused {
    static constexpr bool PERM = true;
    h16* act; const float* rowsq; const float* cw; const float* cb; h16* sb; LAS float* xch;
    __device__ __forceinline__ void operator()(const f32x4 (&acc_c)[2][2][4][2], const Unit& u, int wr, int wc, int fr, int fq) const {
        f32x4 (&acc)[2][2][4][2] = const_cast<f32x4 (&)[2][2][4][2]>(acc_c);
        const int row0 = u.pm * BM + wr * 64 + fr, jl = wc * 32 + 8 * fq, ch0 = u.pn * 128 + jl;
        float rsv[2][4];
#pragma unroll
        for (int ai = 0; ai < 2; ++ai)
#pragma unroll
            for (int m = 0; m < 4; ++m) rsv[ai][m] = rowsq[row0 + ai * HALF + m * 16];
#pragma unroll
        for (int ai = 0; ai < 2; ++ai)
#pragma unroll
            for (int m = 0; m < 4; ++m) { const float rs = rsqrtf(rsv[ai][m] * (1.0f / 1024.0f) + EPS);
#pragma unroll
                for (int bj = 0; bj < 2; ++bj)
#pragma unroll
                    for (int n = 0; n < 2; ++n) acc[ai][bj][m][n] *= rs; }
        if (fr >= 14) {
#pragma unroll
            for (int ai = 0; ai < 2; ++ai)
#pragma unroll
                for (int bj = 0; bj < 2; ++bj)
#pragma unroll
                    for (int n = 0; n < 2; ++n) *(LAS f32x4*)(xch + ((ai * 2 + wr) * 4 + wc) * 128 + (fr - 14) * 64 + bj * 32 + 8 * fq + 4 * n) = acc[ai][bj][3][n];
        }
        if ((wr == 1 && fr >= 14) || (wr == 0 && fr < 2)) {
            const int ai = wr, m = wr ? 3 : 0, srow = wr ? (2 + fr - 14) : fr;
#pragma unroll
            for (int bj = 0; bj < 2; ++bj) { const f32x4 a = wr ? acc[1][bj][3][0] : acc[0][bj][0][0], b = wr ? acc[1][bj][3][1] : acc[0][bj][0][1];
                *(u32x4*)(sb + ((size_t)u.pm * 4 + srow) * FF2 + u.pn * 256 + bj * 128 + jl) = pack8(a, b); }
            (void)ai; (void)m;
        }
        asm volatile("s_waitcnt lgkmcnt(0)" ::: "memory");
        __builtin_amdgcn_s_barrier(); __builtin_amdgcn_s_barrier();
        asm volatile("" ::: "memory");
#pragma unroll
        for (int n = 0; n < 2; ++n) {
            f32x4 wg[3], wv[3], bg, bv;
#pragma unroll
            for (int t = 0; t < 3; ++t) { wg[t] = *(const f32x4*)(cw + t * FF2 + ch0 + 4 * n); wv[t] = *(const f32x4*)(cw + t * FF2 + FF + ch0 + 4 * n); }
            bg = *(const f32x4*)(cb + ch0 + 4 * n); bv = *(const f32x4*)(cb + FF + ch0 + 4 * n);
#pragma unroll
            for (int ai = 0; ai < 2; ++ai) {
                f32x4 xpg = {0.f, 0.f, 0.f, 0.f}, xpv = {0.f, 0.f, 0.f, 0.f};
                const bool top = (ai == 0 && wr == 0);
                if (!top && fr >= 14) { const int ps = (wr == 1) ? ((ai * 2) * 4 + wc) : (((ai - 1) * 2 + 1) * 4 + wc);
                    xpg = *(const LAS f32x4*)(xch + ps * 128 + (fr - 14) * 64 + 8 * fq + 4 * n); xpv = *(const LAS f32x4*)(xch + ps * 128 + (fr - 14) * 64 + 32 + 8 * fq + 4 * n); }
#pragma unroll
                for (int m = 0; m < 4; ++m) {
                    const f32x4 cg = acc[ai][0][m][n], cv = acc[ai][1][m][n];
                    const f32x4 pg = m ? acc[ai][0][m - 1][n] : xpg, pv = m ? acc[ai][1][m - 1][n] : xpv;
                    h16x4 o;
#pragma unroll
                    for (int e = 0; e < 4; ++e) {
                        const float g1 = dppmov<0x111>(dppmov<0x121>(0.f, pg[e]), cg[e]), g2 = dppmov<0x112>(dppmov<0x122>(0.f, pg[e]), cg[e]);
                        const float v1 = dppmov<0x111>(dppmov<0x121>(0.f, pv[e]), cv[e]), v2 = dppmov<0x112>(dppmov<0x122>(0.f, pv[e]), cv[e]);
                        const float gate = wg[0][e] * g2 + wg[1][e] * g1 + wg[2][e] * cg[e] + bg[e];
                        const float val = wv[0][e] * v2 + wv[1][e] * v1 + wv[2][e] * cv[e] + bv[e];
                        o[e] = (h16)(silu_f(gate) * val);
                    }
                    *(h16x4*)(act + (size_t)(row0 + ai * HALF + m * 16) * FF + ch0 + 4 * n) = o;
                }
            }
        }
    }
};

struct EpiOddIn {
    static constexpr bool PERM = true;
    h16* O; int ldc; const float* rowsq; const float* gtab; LAS float* xch;
    __device__ __forceinline__ void operator()(const f32x4 (&acc_c)[2][2][4][2], const Unit& u, int wr, int wc, int fr, int fq) const {
        f32x4 (&acc)[2][2][4][2] = const_cast<f32x4 (&)[2][2][4][2]>(acc_c);
        const int row0 = u.pm * BM + wr * 64 + fr, col0 = u.pn * BM + wc * 32 + 8 * fq;
        const int pn = u.pn;
        const int kind0 = pn < 4 ? 1 : ((pn == 6 || pn == 7 || pn == 8) ? 2 : 0), kind1 = pn < 4 ? 1 : ((pn == 6 || pn == 7) ? 2 : 0);
        float rsv[2][4];
#pragma unroll
        for (int ai = 0; ai < 2; ++ai)
#pragma unroll
            for (int m = 0; m < 4; ++m) rsv[ai][m] = rowsq[row0 + ai * HALF + m * 16];
#pragma unroll
        for (int ai = 0; ai < 2; ++ai)
#pragma unroll
            for (int m = 0; m < 4; ++m) { const float rs = rsqrtf(rsv[ai][m] * (1.0f / 1024.0f) + EPS);
#pragma unroll
                for (int bj = 0; bj < 2; ++bj)
#pragma unroll
                    for (int n = 0; n < 2; ++n) acc[ai][bj][m][n] *= rs; }
        if (kind0 != 0) {
            const int kidx = pn < 2 ? 0 : (pn < 4 ? 1 : (pn < 8 ? 2 : 3));
            const int gcol = (kind0 == 1 ? 32 * (wc & 1) : 32 * wc) + 8 * fq;
            const f32x4 ga = *(const f32x4*)(gtab + kidx * 128 + gcol), gb = *(const f32x4*)(gtab + kidx * 128 + gcol + 4);
            const float gscale = 1.0f;
#pragma unroll
            for (int ai = 0; ai < 2; ++ai)
#pragma unroll
                for (int m = 0; m < 4; ++m)
#pragma unroll
                    for (int bj = 0; bj < 2; ++bj) { const f32x4 a = acc[ai][bj][m][0], b = acc[ai][bj][m][1];
                        float ss = (a[0] * a[0] + a[1] * a[1]) + (a[2] * a[2] + a[3] * a[3]) + (b[0] * b[0] + b[1] * b[1]) + (b[2] * b[2] + b[3] * b[3]);
                        ss += __shfl_xor(ss, 16); ss += __shfl_xor(ss, 32);
                        if (fq == 0) xch[((ai * HALF + wr * 64 + m * 16 + fr) * 2 + bj) * 4 + wc] = ss; }
            asm volatile("s_waitcnt lgkmcnt(0)" ::: "memory");
            __builtin_amdgcn_s_barrier(); __builtin_amdgcn_s_barrier();
            asm volatile("" ::: "memory");
#pragma unroll
            for (int ai = 0; ai < 2; ++ai)
#pragma unroll
                for (int m = 0; m < 4; ++m)
#pragma unroll
                    for (int bj = 0; bj < 2; ++bj) { const int kind = bj ? kind1 : kind0;
                        if (kind != 0) {
                            const f32x4 pp = *(const LAS f32x4*)(xch + ((ai * HALF + wr * 64 + m * 16 + fr) * 2 + bj) * 4);
                            const float sum = kind == 1 ? ((wc & 2) ? (pp[2] + pp[3]) : (pp[0] + pp[1])) : ((pp[0] + pp[1]) + (pp[2] + pp[3]));
                            const float gr = rsqrtf(sum * (kind == 1 ? (1.f / 64.f) : (1.f / 128.f)) + EPS) * gscale;
                            acc[ai][bj][m][0] *= ga * gr; acc[ai][bj][m][1] *= gb * gr; } }
        }
#pragma unroll
        for (int ai = 0; ai < 2; ++ai)
#pragma unroll
            for (int m = 0; m < 4; ++m) { const int r = row0 + ai * HALF + m * 16;
#pragma unroll
                for (int bj = 0; bj < 2; ++bj) *(u32x4*)(O + (size_t)r * ldc + col0 + bj * HALF) = pack8(acc[ai][bj][m][0], acc[ai][bj][m][1]); }
    }
};
}

__device__ __forceinline__ void map_col(int mode, int nd, int Nsrc, int& src, float& sc) {
    sc = 1.f;
    if (mode == 0) { src = nd < Nsrc ? nd : -1; }
    else if (mode == 1) { src = nd < 2560 ? nd : (nd < 3072 ? nd + 8 : (nd < 3080 ? nd - 512 : -1)); }
    else if (mode == 3) { const int pt = nd >> 8, rr = nd & 255; src = rr < 128 ? 128 * pt + rr : FF + 128 * pt + (rr - 128); }
    else { src = nd < Nsrc ? nd : -1; if (nd >= 2304 && nd < 2816) sc = 0.125f; if (nd >= 2880 && nd < 2888) sc = 0.35355339059f; }
}
__device__ __forceinline__ void conv_weight(const int wid_s, LAS float* tile, const float* __restrict__ W, int K, int Nsrc, h16* __restrict__ Wt, int Npad, const float* __restrict__ g, int mode) {
    int tid_ = TIDX; asm volatile("" : "+v"(tid_));
    const int tid = tid_, ktiles = K / 64, ntiles = Npad / 64;
    for (int t = blockIdx.x; t < ktiles * ntiles; t += gridDim.x) {
        const int nt = t / ktiles, kt = t % ktiles;
        {   const int n = tid & 63, nd = nt * 64 + n; int src; float sc; map_col(mode, nd, Nsrc, src, sc);
            const bool ok = src >= 0; const int sidx = ok ? src : 0; if (!ok) sc = 0.f;
            float vals[8], gv[8];
#pragma unroll
            for (int i = 0; i < 8; ++i) { const int k = i * 8 + (tid >> 6); vals[i] = W[(size_t)(kt * 64 + k) * Nsrc + sidx]; gv[i] = g ? g[kt * 64 + k] : 1.f; }
#pragma unroll
            for (int i = 0; i < 8; ++i) { const int k = i * 8 + (tid >> 6); tile[k * 65 + n] = vals[i] * sc * gv[i]; }
        }
        __syncthreads();
#pragma unroll
        for (int i = 0; i < 8; ++i) { const int n = i * 8 + (tid >> 6), k = tid & 63; Wt[(size_t)(nt * 64 + n) * K + kt * 64 + k] = (h16)tile[k * 65 + n]; }
        __syncthreads();
    }
}

__device__ __forceinline__ void phase_prep(const int wid_s, CParams& p, LAS unsigned char* lds) {
    int tid_ = TIDX; asm volatile("" : "+v"(tid_));
    const int tid = tid_, lane = tid & 63, wave = tid >> 6;
    unsigned char* ws = p.ws;
    LAS float* tile = (LAS float*)lds;
    const float* mix_g = p.in[2]; const float* ffn_g = p.in[19];
    for (int l = 0; l < DEPTH; ++l) {
        const int j = l >> 1;
        if ((l & 1) == 0) conv_weight(wid_s, tile, p.in[3] + (size_t)j * D * EV_SRC, D, EV_SRC, (h16*)(ws + WS_WIN_E + j * SZ_WIN_E), EV_N, mix_g + l * D, 1);
        else conv_weight(wid_s, tile, p.in[11] + (size_t)j * D * OD_SRC, D, OD_SRC, (h16*)(ws + WS_WIN_O + j * SZ_WIN_O), OD_N, mix_g + l * D, 2);
        const float* wo = (l & 1) == 0 ? p.in[4] + (size_t)j * D * D : p.in[12] + (size_t)j * D * D;
        conv_weight(wid_s, tile, wo, D, D, (h16*)(ws + WS_WOUT + l * SZ_WOUT), D, nullptr, 0);
        conv_weight(wid_s, tile, p.in[20] + (size_t)l * D * FF2, D, FF2, (h16*)(ws + WS_WUP + l * SZ_WUP), FF2, ffn_g + l * D, 3);
        conv_weight(wid_s, tile, p.in[23] + (size_t)l * FF * D, FF, D, (h16*)(ws + WS_WDN + l * SZ_WDN), D, nullptr, 0);
    }
    const float* x = p.in[0]; float* out = p.out; h16* hb = (h16*)(ws + WS_HB); float* rsq = (float*)(ws + WS_RSQ);
    const int bid8 = opaque_bid() * 8;
    for (int row = bid8 + wave; row < T; row += gridDim.x * 8) {
        float ss = 0.f;
        f32x4 xv4[4];
#pragma unroll
        for (int i = 0; i < 4; ++i) xv4[i] = *(const f32x4*)(x + (size_t)row * D + i * 256 + lane * 4);
#pragma unroll
        for (int i = 0; i < 4; ++i) {
            const size_t o = (size_t)row * D + i * 256 + lane * 4;
            const f32x4 v = xv4[i]; *(f32x4*)(out + o) = v;
            h16x4 hh; hh[0] = (h16)v[0]; hh[1] = (h16)v[1]; hh[2] = (h16)v[2]; hh[3] = (h16)v[3]; *(h16x4*)(hb + o) = hh;
            ss += v[0] * v[0] + v[1] * v[1] + v[2] * v[2] + v[3] * v[3];
        }
        ss = wave_sum(ss);
        if (lane == 0) rsq[row] = ss;
    }
    for (size_t i = (size_t)opaque_bid() * NTHREADS + tid; i < (size_t)8 * T; i += (size_t)gridDim.x * NTHREADS) rsq[T + i] = 0.f;
    { const float* ws_ = p.in[5]; h16* gws = (h16*)(ws + WS_GWS);
      for (int i = opaque_bid() * NTHREADS + tid; i < 2 * 4 * 128 * 128; i += gridDim.x * NTHREADS) { const int s = i & 127, t = (i >> 7) & 127; gws[i] = (h16)(s <= t ? ws_[i] : 0.f); } }
    if (blockIdx.x == 0) {
        const float* rb = p.in[1]; float* bd = (float*)(ws + WS_BIASD);
        for (int i = tid; i < 8 * 129; i += NTHREADS) {
            const int h = i / 129, d = i % 129; int bucket;
            if (d < 16) bucket = d; else { const float nf = (float)d; int far = 16 + (int)(logf(nf / 16.0f) / 2.0794415416798357f * 16.0f); bucket = far < 31 ? far : 31; }
            bd[h * 132 + d] = rb[bucket * 8 + h] * 1.4426950408889634f;
        }
        { float* gt = (float*)(ws + WS_GTAB);
          for (int i = tid; i < 2 * 4 * 128; i += NTHREADS) { const int jj = i >> 9, kd = (i >> 7) & 3, c = i & 127;
              float v;
              if (kd == 0) v = p.in[13][jj * 64 + (c & 63)] * (0.125f * 1.4426950408889634f);
              else if (kd == 1) v = p.in[14][jj * 64 + (c & 63)];
              else if (kd == 2) v = p.in[17][jj * 128 + c] * (0.08838834764831845f * 1.4426950408889634f);
              else v = p.in[18][jj * 128 + c];
              gt[i] = v; } }
        if (tid < 2) { const float* dl = p.in[15] + tid * 4 * 64; float s1 = 0.f, s2 = 0.f; for (int i = 0; i < 64; ++i) { s1 += dl[i] * dl[64 + i]; s2 += dl[128 + i] * dl[192 + i]; }
            const int layer = 2 * tid + 1; const float li = 0.8f - 0.6f * expf(-0.3f * (float)layer);
            float* misc = (float*)(ws + WS_MISC); misc[tid * 2] = expf(s1) - expf(s2) + li; misc[tid * 2 + 1] = li; }
    }
}

__device__ __forceinline__ void phase_ffn_conv(const int wid_s, h16* up, const h16* halo, const float* __restrict__ cw, const float* __restrict__ cb) {
    const int nth = gridDim.x * NTHREADS;
    int tid_ = TIDX; asm volatile("" : "+v"(tid_));
    for (int idx = opaque_bid() * NTHREADS + tid_; idx < (T / 64) * (FF / 8); idx += nth) {
        const int cgp = idx % (FF / 8), rb = idx / (FF / 8), ch = cgp * 8, t0 = rb * 64;
        float wg[3][8], wv[3][8], bg[8], bv[8];
#pragma unroll
        for (int j = 0; j < 3; ++j)
#pragma unroll
            for (int c = 0; c < 8; ++c) { wg[j][c] = cw[j * FF2 + ch + c]; wv[j][c] = cw[j * FF2 + FF + ch + c]; }
#pragma unroll
        for (int c = 0; c < 8; ++c) { bg[c] = cb[ch + c]; bv[c] = cb[FF + ch + c]; }
        float g2[8], g1[8], v2[8], v1[8];
        if ((rb & 63) == 0) {
#pragma unroll
            for (int c = 0; c < 8; ++c) { g2[c] = g1[c] = v2[c] = v1[c] = 0.f; }
        } else {
            const h16* hp = halo + (size_t)(rb - 1) * 2 * FF2;
            const h16x8 a = *(const h16x8*)(hp + ch), b = *(const h16x8*)(hp + FF + ch), c2 = *(const h16x8*)(hp + FF2 + ch), d2 = *(const h16x8*)(hp + FF2 + FF + ch);
#pragma unroll
            for (int c = 0; c < 8; ++c) { g2[c] = (float)a[c]; v2[c] = (float)b[c]; g1[c] = (float)c2[c]; v1[c] = (float)d2[c]; }
        }
        h16* rp = up + (size_t)t0 * FF2 + ch;
#pragma unroll 1
        for (int r4 = 0; r4 < 16; ++r4) {
            h16x8 gcv[4], vcv[4];
#pragma unroll
            for (int q = 0; q < 4; ++q) { gcv[q] = *(const h16x8*)(rp + (size_t)q * FF2); vcv[q] = *(const h16x8*)(rp + (size_t)q * FF2 + FF); }
#pragma unroll
            for (int q = 0; q < 4; ++q) {
                h16x8 o;
#pragma unroll
                for (int c = 0; c < 8; ++c) {
                    const float g0 = (float)gcv[q][c], v0 = (float)vcv[q][c];
                    const float gate = wg[0][c] * g2[c] + wg[1][c] * g1[c] + wg[2][c] * g0 + bg[c];
                    const float val = wv[0][c] * v2[c] + wv[1][c] * v1[c] + wv[2][c] * v0 + bv[c];
                    o[c] = (h16)(silu_f(gate) * val);
                    g2[c] = g1[c]; g1[c] = g0; v2[c] = v1[c]; v1[c] = v0;
                }
                *(h16x8*)(rp + (size_t)q * FF2) = o;
            }
            rp += 4 * FF2;
        }
    }
}


__device__ __forceinline__ void phase_ffn_fixup(const int wid_s, h16* act, const h16* sb, const float* __restrict__ cw, const float* __restrict__ cb) {
    int tid_ = TIDX; asm volatile("" : "+v"(tid_));
    const int nth = gridDim.x * NTHREADS;
    for (int idx = opaque_bid() * NTHREADS + tid_; idx < (T / 256) * (FF / 8); idx += nth) {
        const int cgp = idx % (FF / 8), pm = idx / (FF / 8), ch = cgp * 8;
        if ((pm & 15) == 0) continue;
        const int col = 256 * (ch >> 7) + (ch & 127);
        const h16* s0 = sb + (size_t)pm * 4 * FF2 + col; const h16* sp = sb + (size_t)(pm - 1) * 4 * FF2 + col;
        const h16x8 g254 = *(const h16x8*)(sp + 2 * FF2), v254 = *(const h16x8*)(sp + 2 * FF2 + 128), g255 = *(const h16x8*)(sp + 3 * FF2), v255 = *(const h16x8*)(sp + 3 * FF2 + 128);
        const h16x8 g0 = *(const h16x8*)(s0), v0 = *(const h16x8*)(s0 + 128), g1 = *(const h16x8*)(s0 + FF2), v1 = *(const h16x8*)(s0 + FF2 + 128);
        h16x8 o0, o1;
#pragma unroll
        for (int c = 0; c < 8; ++c) {
            const float wg0 = cw[ch + c], wg1 = cw[FF2 + ch + c], wg2 = cw[2 * FF2 + ch + c], wv0 = cw[FF + ch + c], wv1 = cw[FF2 + FF + ch + c], wv2 = cw[2 * FF2 + FF + ch + c];
            const float bgc = cb[ch + c], bvc = cb[FF + ch + c];
            const float ga = wg0 * (float)g254[c] + wg1 * (float)g255[c] + wg2 * (float)g0[c] + bgc, va = wv0 * (float)v254[c] + wv1 * (float)v255[c] + wv2 * (float)v0[c] + bvc;
            const float gb = wg0 * (float)g255[c] + wg1 * (float)g0[c] + wg2 * (float)g1[c] + bgc, vb = wv0 * (float)v255[c] + wv1 * (float)v0[c] + wv2 * (float)v1[c] + bvc;
            o0[c] = (h16)(silu_f(ga) * va); o1[c] = (h16)(silu_f(gb) * vb);
        }
        *(h16x8*)(act + (size_t)(pm * 256) * FF + ch) = o0; *(h16x8*)(act + (size_t)(pm * 256 + 1) * FF + ch) = o1;
    }
}

__device__ __forceinline__ f32x4 mma16(const h16x8 a, const h16x8 b, const f32x4 c) { return __builtin_amdgcn_mfma_f32_16x16x32_f16(a, b, c, 0, 0, 0); }
constexpr int EM_QN = 0, EM_KN = 17408, EM_KB = 34816, EM_KBGT = 52224, EM_VBT = 70656, EM_LM = 89088, EM_M0 = 89088, EM_MT0 = 98304, EM_M1 = 107520, EM_MT1 = 116736, EM_TA0 = 125952, EM_TA1 = 135168, EM_SM = 144384;

__device__ __forceinline__ void phase_even_mix(const int wid_s, CParams& p, int j, LAS unsigned char* lds) {
    int tid_ = TIDX; asm volatile("" : "+v"(tid_));
    const int tid = tid_, lane = tid & 63, wave = tid >> 6, lr = lane & 15, lq = lane >> 4;
    unsigned char* ws = p.ws; unsigned char* R = ws + WS_R;
    h16* proj = (h16*)(R + R_PROJ); h16* y = (h16*)(R + R_Y);
    h16* qg = (h16*)(R + R_QG); h16* kdt = (h16*)(R + R_KDT); h16* intra = (h16*)(R + R_INTRA);
    const float* ba = (const float*)(ws + WS_BA); float* gcl = (float*)(ws + WS_GCL);
    const h16* gws = (const h16*)(ws + WS_GWS) + (size_t)j * 4 * 128 * 128;
    const float* bs = p.in[6] + j * 4 * 128;
    const float* cw = p.in[7] + (size_t)j * 4 * 1536;
    const float* alog = p.in[8] + j * 4; const float* dtb = p.in[9] + j * 4;
    LAS h16* Vt = (LAS h16*)(lds);
    LAS h16* Qn = (LAS h16*)(lds + EM_QN); LAS h16* Kn = (LAS h16*)(lds + EM_KN); LAS h16* KB = (LAS h16*)(lds + EM_KB);
    LAS h16* KBGt = (LAS h16*)(lds + EM_KBGT); LAS h16* VBt = (LAS h16*)(lds + EM_VBT);
    LAS h16* const Mb[2] = {(LAS h16*)(lds + EM_M0), (LAS h16*)(lds + EM_M1)}; LAS h16* const MTb[2] = {(LAS h16*)(lds + EM_MT0), (LAS h16*)(lds + EM_MT1)};
    LAS h16* const TAb[2] = {(LAS h16*)(lds + EM_TA0), (LAS h16*)(lds + EM_TA1)}; LAS h16* T16 = TAb[1];
    LAS float* ssq = (LAS float*)(lds + EM_SM); LAS float* betas = ssq + 128; LAS float* gcs = ssq + 192;
    for (int item = blockIdx.x; item < 2048; item += gridDim.x) {
        int tidi_ = tid_; asm volatile("" : "+v"(tidi_));
        const int tid = tidi_, lane = tid & 63, wave = tid >> 6, lr = lane & 15, lq = lane >> 4;
        const int g = item & 3, n = (item >> 2) & 31, b = item >> 7;
        const int t0 = b * SEQ + n * 128;
        {
            const int s = tid >> 2, q = tid & 3;
            float xv[32]; float sum = 0.f;
#pragma unroll
            for (int i = 0; i < 4; ++i) { const h16x8 v = *(const h16x8*)(proj + (size_t)(t0 + s) * EV_N + 512 + g * 128 + q * 32 + i * 8);
#pragma unroll
                for (int e = 0; e < 8; ++e) { xv[i * 8 + e] = (float)v[e]; sum += xv[i * 8 + e]; } }
            sum += __shfl_xor(sum, 1); sum += __shfl_xor(sum, 2);
            const float mean = sum * (1.f / 128.f); float var = 0.f;
#pragma unroll
            for (int i = 0; i < 32; ++i) { xv[i] -= mean; var += xv[i] * xv[i]; }
            var += __shfl_xor(var, 1); var += __shfl_xor(var, 2);
            const float rstd = rsqrtf(var * (1.f / 128.f) + EPS);
#pragma unroll
            for (int i = 0; i < 32; ++i) Vt[(q * 32 + i) * 136 + s] = (h16)(xv[i] * rstd);
        }
        __syncthreads();
        {
            const h16* gw = gws + (size_t)g * 128 * 128;
            h16x8 af[4];
#pragma unroll
            for (int ks = 0; ks < 4; ++ks) af[ks] = *(const h16x8*)(gw + (16 * wave + lr) * 128 + 32 * ks + 8 * lq);
            h16 uu[8][4]; float bsv[4];
#pragma unroll
            for (int r = 0; r < 4; ++r) bsv[r] = bs[g * 128 + 16 * wave + 4 * lq + r];
#pragma unroll
            for (int nt = 0; nt < 8; ++nt)
#pragma unroll
                for (int r = 0; r < 4; ++r) uu[nt][r] = proj[(size_t)(t0 + 16 * wave + 4 * lq + r) * EV_N + g * 128 + 16 * nt + lr];
#pragma unroll
            for (int nt = 0; nt < 8; ++nt) {
                f32x4 acc = {0.f, 0.f, 0.f, 0.f};
#pragma unroll
                for (int ks = 0; ks < 4; ++ks) if (32 * ks <= 16 * wave + 15) acc = mma16(af[ks], *(const LAS h16x8*)(Vt + (16 * nt + lr) * 136 + 32 * ks + 8 * lq), acc);
#pragma unroll
                for (int r = 0; r < 4; ++r) {
                    const int t = 16 * wave + 4 * lq + r, c = 16 * nt + lr;
                    const float mixed = acc[r] + bsv[r];
                    y[(size_t)(t0 + t) * D + g * 128 + c] = (h16)((float)uu[nt][r] * mixed);
                }
            }
        }
        __syncthreads();
        const int h = g;
#pragma unroll 1
        for (int cc = 0; cc < 2; ++cc) {
            int tidc_ = tidi_; asm volatile("" : "+v"(tidc_));
            const int tid = tidc_, lane = tid & 63, wave = tid >> 6, lr = lane & 15, lq = lane >> 4;
            const int tc0 = t0 + cc * 64; const int tin = (n * 128 + cc * 64);
            const int chh = (tc0 >> 6) * 4 + h;
            if (tid < 128) ssq[tid] = 0.f;
            __syncthreads();
            LAS h16* KDs = (LAS h16*)(lds + EM_LM);
#pragma unroll 1
            for (int pass = 0; pass < 2; ++pass) {
                if (tid < 384) {
                    const int gq = tid % 48, part = gq >> 4, c8 = (gq & 15) * 8, tok8 = (tid / 48) * 8;
                    float wv[4][8];
#pragma unroll
                    for (int jj = 0; jj < 4; ++jj)
#pragma unroll
                        for (int e = 0; e < 8; ++e) wv[jj][e] = cw[jj * 1536 + part * 512 + h * 128 + c8 + e];
                    const h16* xp = proj + (size_t)tc0 * EV_N + 1024 + part * 512 + h * 128 + c8;
                    const float glast = pass ? gcs[63] : 0.f;
                    h16x8 xa[11];
#pragma unroll
                    for (int r = 0; r < 11; ++r) { const int tt = tok8 - 3 + r; const bool okr = tin + tt >= 0;
                        xa[r] = *(const h16x8*)(xp + (long)(okr ? tt : 0) * EV_N);
                        if (!okr) {
#pragma unroll
                            for (int e = 0; e < 8; ++e) xa[r][e] = (h16)0.f; } }
#pragma unroll 1
                    for (int hf = 0; hf < 2; ++hf) {
                    h16x8 xr[7];
#pragma unroll
                    for (int r = 0; r < 7; ++r) xr[r] = hf ? xa[r + 4] : xa[r];
#pragma unroll
                    for (int i = 0; i < 4; ++i) {
                        const int t = tok8 + 4 * hf + i; float sq = 0.f; float cv[8];
#pragma unroll
                        for (int e = 0; e < 8; ++e) { const float a = wv[0][e] * (float)xr[i][e] + wv[1][e] * (float)xr[i + 1][e] + wv[2][e] * (float)xr[i + 2][e] + wv[3][e] * (float)xr[i + 3][e]; const float sv = silu_f(a); cv[e] = sv; sq += sv * sv; }
                        if (pass == 0) { if (part < 2) atomicAdd((float*)(ssq + part * 64 + t), sq); }
                        else if (part == 0) {
                            const float rn = rsqrtf(ssq[t] + EPS) * 0.08838834764831845f; const float eg = __expf(gcs[t]);
                            h16x8 a, bq;
#pragma unroll
                            for (int e = 0; e < 8; ++e) { const float v = cv[e] * rn; a[e] = (h16)v; bq[e] = (h16)(v * eg); }
                            *(LAS h16x8*)(Qn + t * 136 + c8) = a; *(h16x8*)(qg + (size_t)(tc0 + t) * 512 + h * 128 + c8) = bq;
                        } else if (part == 1) {
                            const float rn = rsqrtf(ssq[64 + t] + EPS); const float be = betas[t]; const float gt = gcs[t]; const float e1 = be * __expf(gt), e2 = __expf(glast - gt);
                            h16x8 a, bq;
#pragma unroll
                            for (int e = 0; e < 8; ++e) { const float v = cv[e] * rn; a[e] = (h16)v; bq[e] = (h16)(v * be); KBGt[(c8 + e) * 72 + t] = (h16)(v * e1); KDs[(c8 + e) * 72 + t] = (h16)(v * e2); }
                            *(LAS h16x8*)(Kn + t * 136 + c8) = a; *(LAS h16x8*)(KB + t * 136 + c8) = bq;
                        } else {
                            const float be = betas[t];
#pragma unroll
                            for (int e = 0; e < 8; ++e) VBt[(c8 + e) * 72 + t] = (h16)(cv[e] * be);
                        }
                    }
                    }
                } else if (tid < 448 && pass == 0) {
                    const int t = tid - 384;
                    const float braw = ba[(size_t)(tc0 + t) * 8 + h], araw = ba[(size_t)(tc0 + t) * 8 + 4 + h];
                    const float beta = 1.f / (1.f + __expf(-braw));
                    const float xx = araw + dtb[h];
                    const float sp = xx > 20.f ? xx : log1pf(__expf(xx));
                    float gt = -__expf(alog[h]) * sp;
#pragma unroll
                    for (int o = 1; o < 64; o <<= 1) { const float v = __shfl_up(gt, o); if (t >= o) gt += v; }
                    betas[t] = beta; gcs[t] = gt;
                    if (t == 63) gcl[chh] = gt;
                }
                __syncthreads();
            }
            for (int i = tid; i < 128 * 8; i += NTHREADS) { const int k = i >> 3, c8 = (i & 7) * 8; *(h16x8*)(kdt + ((size_t)chh * 128 + k) * 64 + c8) = *(const LAS h16x8*)(KDs + k * 72 + c8); }
            __syncthreads();
            {
                const int sel = wave >> 2, mt = wave & 3;
                const LAS h16* Am = sel ? Qn : KB;
                h16x8 af[4];
#pragma unroll
                for (int ks = 0; ks < 4; ++ks) af[ks] = *(const LAS h16x8*)(Am + (16 * mt + lr) * 136 + 32 * ks + 8 * lq);
#pragma unroll
                for (int nt = 0; nt < 4; ++nt) {
                    f32x4 acc = {0.f, 0.f, 0.f, 0.f};
#pragma unroll
                    for (int ks = 0; ks < 4; ++ks) acc = mma16(af[ks], *(const LAS h16x8*)(Kn + (16 * nt + lr) * 136 + 32 * ks + 8 * lq), acc);
                    const int jc = 16 * nt + lr; const float gj = gcs[jc];
                    h16x4 lt;
#pragma unroll
                    for (int r = 0; r < 4; ++r) { const int i = 16 * mt + 4 * lq + r;
                        const float dec = (jc <= i) ? __expf(gcs[i] - gj) : 0.f;
                        const h16 lv = (h16)((jc < i) ? acc[r] * dec : 0.f); lt[r] = lv;
                        if (sel == 0) Mb[0][i * 72 + jc] = lv;
                        else intra[((size_t)chh * 64 + i) * 64 + jc] = (h16)(acc[r] * dec); }
                    if (sel == 0) *(LAS h16x4*)(MTb[0] + jc * 72 + 16 * mt + 4 * lq) = lt;
                }
            }
            __syncthreads();
            {
                const int mt = wave >> 1, nt0 = 2 * (wave & 1);
                f32x4 tacc[2];
#pragma unroll
                for (int t = 0; t < 2; ++t) { const int jc = 16 * (nt0 + t) + lr;
#pragma unroll
                    for (int r = 0; r < 4; ++r) { const int i = 16 * mt + 4 * lq + r; const float v = ((i == jc) ? 1.f : 0.f) - (float)Mb[0][i * 72 + jc]; tacc[t][r] = v; TAb[0][i * 72 + jc] = (h16)v; } }
#define NEU_SQUARE(src, dst) do { _Pragma("unroll") for (int t = 0; t < 2; ++t) { f32x4 a_ = {0.f, 0.f, 0.f, 0.f}; \
                    _Pragma("unroll") for (int ks = 0; ks < 2; ++ks) a_ = mma16(*(const LAS h16x8*)(Mb[src] + (16 * mt + lr) * 72 + 32 * ks + 8 * lq), *(const LAS h16x8*)(MTb[src] + (16 * (nt0 + t) + lr) * 72 + 32 * ks + 8 * lq), a_); \
                    const int jc_ = 16 * (nt0 + t) + lr; h16x4 lt_; \
                    _Pragma("unroll") for (int r = 0; r < 4; ++r) { lt_[r] = (h16)a_[r]; Mb[dst][(16 * mt + 4 * lq + r) * 72 + jc_] = lt_[r]; } \
                    *(LAS h16x4*)(MTb[dst] + jc_ * 72 + 16 * mt + 4 * lq) = lt_; } } while (0)
                NEU_SQUARE(0, 1);
                __syncthreads();
#pragma unroll
                for (int st = 0; st < 5; ++st) {
                    const int mc = (st + 1) & 1, tc = st & 1;
#pragma unroll
                    for (int t = 0; t < 2; ++t) {
#pragma unroll
                        for (int ks = 0; ks < 2; ++ks) tacc[t] = mma16(*(const LAS h16x8*)(TAb[tc] + (16 * mt + lr) * 72 + 32 * ks + 8 * lq), *(const LAS h16x8*)(MTb[mc] + (16 * (nt0 + t) + lr) * 72 + 32 * ks + 8 * lq), tacc[t]);
                        const int jc = 16 * (nt0 + t) + lr;
#pragma unroll
                        for (int r = 0; r < 4; ++r) TAb[tc ^ 1][(16 * mt + 4 * lq + r) * 72 + jc] = (h16)tacc[t][r];
                    }
                    if (st < 4) NEU_SQUARE(mc, mc ^ 1);
                    __syncthreads();
                }
#undef NEU_SQUARE
            }
            {
                const int sel = wave >> 2, mt = wave & 3;
                const LAS h16* Bm = sel ? KBGt : VBt;
                h16x8 af[2];
#pragma unroll
                for (int ks = 0; ks < 2; ++ks) af[ks] = *(const LAS h16x8*)(T16 + (16 * mt + lr) * 72 + 32 * ks + 8 * lq);
#pragma unroll
                for (int nt = 0; nt < 8; ++nt) {
                    f32x4 acc = {0.f, 0.f, 0.f, 0.f};
#pragma unroll
                    for (int ks = 0; ks < 2; ++ks) acc = mma16(af[ks], *(const LAS h16x8*)(Bm + (16 * nt + lr) * 72 + 32 * ks + 8 * lq), acc);
#pragma unroll
                    for (int r = 0; r < 4; ++r) { const int i = 16 * mt + 4 * lq + r, d = 16 * nt + lr;
                        proj[(size_t)(tc0 + i) * EV_N + (sel ? 0 : 512) + h * 128 + d] = (h16)acc[r]; }
                }
            }
            __syncthreads();
        }
    }
}

__device__ __forceinline__ void phase_gdn_scan(const int wid_s, CParams& p, LAS unsigned char* lds) {
    int tid_ = TIDX; asm volatile("" : "+v"(tid_));
    const int tid = tid_, lane = tid & 63, wave = tid >> 6, lr = lane & 15, lq = lane >> 4;
    unsigned char* ws = p.ws; unsigned char* R = ws + WS_R;
    const h16* proj = (const h16*)(R + R_PROJ); h16* y = (h16*)(R + R_Y);
    const h16* qg = (const h16*)(R + R_QG); const h16* kdt = (const h16*)(R + R_KDT); const h16* intra = (const h16*)(R + R_INTRA);
    const float* gcl = (const float*)(ws + WS_GCL);
    LAS h16* St = (LAS h16*)lds;
    LAS h16* Vnt = (LAS h16*)(lds + 17408);
    for (int chain = blockIdx.x; chain < 256; chain += gridDim.x) {
        const int b = chain >> 4, h = (chain >> 2) & 3, sl = chain & 3;
        for (int i = tid; i < 32 * 136; i += NTHREADS) St[i] = (h16)0.f;
        f32x4 st[2] = {{0.f, 0.f, 0.f, 0.f}, {0.f, 0.f, 0.f, 0.f}};
        const int vt = wave & 1, wq = wave >> 1;
        __syncthreads();
        int cur = 0;
        h16x8 wf[4], qf[4], inf[2], kf[2][2]; h16x4 uu; float egl;
        h16x8 wfn[4], qfn[4], infn[2], kfn[2][2]; h16x4 uun; float egln;
#define SCAN_LOAD(WF, UU, QF, INF, KF, EGL, nn) do { const int tc_ = b * SEQ + (nn) * 64; const int ch_ = (tc_ >> 6) * 4 + h; \
            _Pragma("unroll") for (int ks = 0; ks < 4; ++ks) WF[ks] = *(const h16x8*)(proj + (size_t)(tc_ + 16 * wq + lr) * EV_N + h * 128 + 32 * ks + 8 * lq); \
            UU = *(const h16x4*)(proj + (size_t)(tc_ + 16 * wq + lr) * EV_N + 512 + h * 128 + 32 * sl + 16 * vt + 4 * lq); \
            _Pragma("unroll") for (int ks = 0; ks < 4; ++ks) QF[ks] = *(const h16x8*)(qg + (size_t)(tc_ + 16 * wq + lr) * 512 + h * 128 + 32 * ks + 8 * lq); \
            _Pragma("unroll") for (int ks = 0; ks < 2; ++ks) INF[ks] = *(const h16x8*)(intra + ((size_t)ch_ * 64 + 16 * wq + lr) * 64 + 32 * ks + 8 * lq); \
            _Pragma("unroll") for (int i = 0; i < 2; ++i) _Pragma("unroll") for (int ks = 0; ks < 2; ++ks) KF[i][ks] = *(const h16x8*)(kdt + ((size_t)ch_ * 128 + 16 * (2 * wq + i) + lr) * 64 + 32 * ks + 8 * lq); \
            EGL = gcl[ch_]; } while (0)
        h16x8 wf3[4], qf3[4], inf3[2], kf3[2][2]; h16x4 uu3; float egl3;
#define SCAN_STEP(WF, UU, QF, INF, KF, EGL, nn) do { const int tc0 = b * SEQ + (nn) * 64; \
            const LAS h16* Sc = St + cur * (32 * 136); LAS h16* Sn = St + (cur ^ 1) * (32 * 136); \
            { f32x4 acc = {0.f, 0.f, 0.f, 0.f}; \
              _Pragma("unroll") for (int ks = 0; ks < 4; ++ks) acc = mma16(*(const LAS h16x8*)(Sc + (16 * vt + lr) * 136 + 32 * ks + 8 * lq), WF[ks], acc); \
              _Pragma("unroll") for (int r = 0; r < 4; ++r) Vnt[(16 * vt + 4 * lq + r) * 72 + 16 * wq + lr] = (h16)((float)UU[r] - acc[r]); } \
            __syncthreads(); \
            { f32x4 acc = {0.f, 0.f, 0.f, 0.f}; \
              _Pragma("unroll") for (int ks = 0; ks < 4; ++ks) acc = mma16(QF[ks], *(const LAS h16x8*)(Sc + (16 * vt + lr) * 136 + 32 * ks + 8 * lq), acc); \
              _Pragma("unroll") for (int ks = 0; ks < 2; ++ks) acc = mma16(INF[ks], *(const LAS h16x8*)(Vnt + (16 * vt + lr) * 72 + 32 * ks + 8 * lq), acc); \
              _Pragma("unroll") for (int r = 0; r < 4; ++r) y[(size_t)(tc0 + 16 * wq + 4 * lq + r) * D + 512 + h * 128 + 32 * sl + 16 * vt + lr] = (h16)acc[r]; } \
            _Pragma("unroll") for (int i = 0; i < 2; ++i) { f32x4 acc = st[i] * __expf(EGL); \
              _Pragma("unroll") for (int ks = 0; ks < 2; ++ks) acc = mma16(*(const LAS h16x8*)(Vnt + (16 * vt + lr) * 72 + 32 * ks + 8 * lq), KF[i][ks], acc); \
              st[i] = acc; \
              _Pragma("unroll") for (int r = 0; r < 4; ++r) Sn[(16 * vt + 4 * lq + r) * 136 + 16 * (2 * wq + i) + lr] = (h16)acc[r]; } \
            __syncthreads(); cur ^= 1; } while (0)
        SCAN_LOAD(wf, uu, qf, inf, kf, egl, 0);
        SCAN_LOAD(wfn, uun, qfn, infn, kfn, egln, 1);
#pragma unroll 1
        for (int n = 0; n < 64; n += 3) {
            { const int nn = n + 2 < 64 ? n + 2 : 63; SCAN_LOAD(wf3, uu3, qf3, inf3, kf3, egl3, nn); }
            SCAN_STEP(wf, uu, qf, inf, kf, egl, n);
            if (n + 1 < 64) {
                { const int nn = n + 3 < 64 ? n + 3 : 63; SCAN_LOAD(wf, uu, qf, inf, kf, egl, nn); }
                SCAN_STEP(wfn, uun, qfn, infn, kfn, egln, n + 1);
            }
            if (n + 2 < 64) {
                { const int nn = n + 4 < 64 ? n + 4 : 63; SCAN_LOAD(wfn, uun, qfn, infn, kfn, egln, nn); }
                SCAN_STEP(wf3, uu3, qf3, inf3, kf3, egl3, n + 2);
            }
        }
#undef SCAN_STEP
#undef SCAN_LOAD
    }
}

__device__ __forceinline__ void phase_gdn_gate(const int wid_s, CParams& p, int j) {
    int tid_ = TIDX; asm volatile("" : "+v"(tid_));
    const int tid = tid_, lane = tid & 63, wave = tid >> 6;
    unsigned char* R = p.ws + WS_R; const h16* proj = (const h16*)(R + R_PROJ); h16* y = (h16*)(R + R_Y);
    const float* gn = p.in[10] + j * 128;
    float gg[8];
#pragma unroll
    for (int e = 0; e < 8; ++e) gg[e] = gn[(8 * lane + e) & 127];
    const int bid8 = opaque_bid() * 8;
    for (int t = bid8 + wave; t < T; t += gridDim.x * 8) {
        h16x8* yp = (h16x8*)(y + (size_t)t * D + 512 + 8 * lane);
        h16x8 ov = *yp; const h16x8 zv = *(const h16x8*)(proj + (size_t)t * EV_N + 2560 + 8 * lane);
        float x[8], ss = 0.f;
#pragma unroll
        for (int e = 0; e < 8; ++e) { x[e] = (float)ov[e]; ss += x[e] * x[e]; }
        ss += __shfl_xor(ss, 1); ss += __shfl_xor(ss, 2); ss += __shfl_xor(ss, 4); ss += __shfl_xor(ss, 8);
        const float rs = rsqrtf(ss * (1.f / 128.f) + EPS);
#pragma unroll
        for (int e = 0; e < 8; ++e) ov[e] = (h16)(x[e] * rs * gg[e] * silu_f((float)zv[e]));
        *yp = ov;
    }
}

__device__ __forceinline__ f32x16 mma32(const h16x8 a, const h16x8 b, const f32x16 c) { return __builtin_amdgcn_mfma_f32_32x32x16_f16(a, b, c, 0, 0, 0); }
constexpr size_t R_SC = R_G;

__device__ __forceinline__ void phase_odd_prep(const int wid_s, CParams& p, int j) {
    int tid_ = TIDX; asm volatile("" : "+v"(tid_));
    const int tid = tid_, lane = tid & 63, wave = tid >> 6;
    h16* proj = (h16*)(p.ws + WS_R + R_PROJ);
    const float* gq = p.in[13] + j * 64; const float* gk = p.in[14] + j * 64; const float* gsq = p.in[17] + j * 128; const float* gsk = p.in[18] + j * 128;
    float fq[8], fk[8], fs[8];
#pragma unroll
    for (int e = 0; e < 8; ++e) { fq[e] = gq[(8 * lane + e) & 63] * (0.125f * 1.4426950408889634f); fk[e] = gk[(8 * lane + e) & 63]; fs[e] = gsq[(8 * lane + e) & 127] * (0.08838834764831845f * 1.4426950408889634f); }
    const float fk0 = gsk[2 * lane], fk1 = gsk[2 * lane + 1];
    const int bid8 = opaque_bid() * 8;
    for (int t = bid8 + wave; t < T; t += gridDim.x * 8) {
        h16* row = proj + (size_t)t * OD_N;
        h16x8 va = *(const h16x8*)(row + 8 * lane), vb = *(const h16x8*)(row + 512 + 8 * lane), vc = *(const h16x8*)(row + 1536 + 8 * lane);
        h16x2 vd = *(const h16x2*)(row + 2048 + 2 * lane);
        {   float x[8], ss = 0.f;
#pragma unroll
            for (int e = 0; e < 8; ++e) { x[e] = (float)va[e]; ss += x[e] * x[e]; }
            ss += __shfl_xor(ss, 1); ss += __shfl_xor(ss, 2); ss += __shfl_xor(ss, 4);
            const float rs = rsqrtf(ss * (1.f / 64.f) + EPS);
#pragma unroll
            for (int e = 0; e < 8; ++e) va[e] = (h16)(x[e] * rs * fq[e]);
            *(h16x8*)(row + 8 * lane) = va; }
        {   float x[8], ss = 0.f;
#pragma unroll
            for (int e = 0; e < 8; ++e) { x[e] = (float)vb[e]; ss += x[e] * x[e]; }
            ss += __shfl_xor(ss, 1); ss += __shfl_xor(ss, 2); ss += __shfl_xor(ss, 4);
            const float rs = rsqrtf(ss * (1.f / 64.f) + EPS);
#pragma unroll
            for (int e = 0; e < 8; ++e) vb[e] = (h16)(x[e] * rs * fk[e]);
            *(h16x8*)(row + 512 + 8 * lane) = vb; }
        {   float x[8], ss = 0.f;
#pragma unroll
            for (int e = 0; e < 8; ++e) { x[e] = (float)vc[e]; ss += x[e] * x[e]; }
            ss += __shfl_xor(ss, 1); ss += __shfl_xor(ss, 2); ss += __shfl_xor(ss, 4); ss += __shfl_xor(ss, 8);
            const float rs = rsqrtf(ss * (1.f / 128.f) + EPS);
#pragma unroll
            for (int e = 0; e < 8; ++e) vc[e] = (h16)(x[e] * rs * fs[e]);
            *(h16x8*)(row + 1536 + 8 * lane) = vc; }
        {   const float x0 = (float)vd[0], x1 = (float)vd[1];
            const float ss = wave_sum(x0 * x0 + x1 * x1);
            const float rs = rsqrtf(ss * (1.f / 128.f) + EPS);
            vd[0] = (h16)(x0 * rs * fk0); vd[1] = (h16)(x1 * rs * fk1);
            *(h16x2*)(row + 2048 + 2 * lane) = vd; }
    }
}

__device__ __forceinline__ void diff_attn_item(CParams& p, int j, int layer, LAS unsigned char* lds, int b, int h, int qb, int tid_in, int lane_in, int wave) {
    int tid = tid_in; asm volatile("" : "+v"(tid)); const int lane = tid & 63;
    unsigned char* R = p.ws + WS_R; const h16* proj = (const h16*)(R + R_PROJ); h16* y = (h16*)(R + R_Y);
    const float* bd = (const float*)(p.ws + WS_BIASD) + h * 132; const float* misc = (const float*)(p.ws + WS_MISC);
    LAS h16* Ks0 = (LAS h16*)lds;
    LAS h16* Vt0 = (LAS h16*)(lds + 34816);
    LAS float* bdl = (LAS float*)(lds + 71680);
    LAS float* Ox = (LAS float*)(lds + 73728);
    const int mp = wave >> 2, qs = wave & 3, r = lane & 31, hh = lane >> 5;
    const int tb0 = b * SEQ; const int q0 = qb * 128 + 32 * qs;
    if (tid < 129) bdl[tid] = bd[tid];
    h16x8 qf[4];
#pragma unroll
    for (int s = 0; s < 4; ++s) qf[s] = *(const h16x8*)(proj + (size_t)(tb0 + q0 + r) * OD_N + h * 128 + mp * 64 + 16 * s + 8 * hh);
    f32x16 o[4];
#pragma unroll
    for (int d = 0; d < 4; ++d)
#pragma unroll
        for (int i = 0; i < 16; ++i) o[d][i] = 0.f;
    float m_run = -INFINITY, l_run = 0.f;
    const int qp = q0 + r;
    const int vlo = r * 72 + ((hh ^ (r >> 3)) << 2), vhi = r * 72 + (((hh ^ (r >> 3)) ^ 2) << 2);
    const int nkt = 2 * (qb + 1);
    h16x8 pk[2], pv[2];
#pragma unroll
    for (int i = 0; i < 2; ++i) { const int key = i * 32 + (tid >> 4), ch = tid & 15;
        pk[i] = *(const h16x8*)(proj + (size_t)(tb0 + key) * OD_N + 512 + h * 128 + ch * 8);
        pv[i] = *(const h16x8*)(proj + (size_t)(tb0 + key) * OD_N + 1024 + h * 128 + ch * 8); }
#define ATT_STAGE(buf, KC, VC, ktn) do { LAS h16* Kd_ = Ks0 + (buf) * 8704; LAS h16* Vd_ = Vt0 + (buf) * 9216; \
        _Pragma("unroll") for (int i = 0; i < 2; ++i) { const int key = i * 32 + (tid >> 4), ch = tid & 15; \
            *(LAS h16x8*)(Kd_ + key * 136 + ch * 8) = pk[i]; \
            _Pragma("unroll") for (int e = 0; e < 8; ++e) Vd_[(ch * 8 + e) * 72 + ((((key >> 2) ^ ch) << 2) | (key & 3))] = pv[i][e]; } \
        const int kn_ = ((ktn) < nkt ? (ktn) : nkt - 1) * 64; \
        _Pragma("unroll") for (int i = 0; i < 2; ++i) { const int key = i * 32 + (tid >> 4), ch = tid & 15; \
            pk[i] = *(const h16x8*)(proj + (size_t)(tb0 + kn_ + key) * OD_N + (KC) + ch * 8); \
            pv[i] = *(const h16x8*)(proj + (size_t)(tb0 + kn_ + key) * OD_N + (VC) + ch * 8); } } while (0)
    ATT_STAGE(0, 512 + h * 128, 1024 + h * 128, 1);
    __syncthreads();
    for (int kt = 0; kt < nkt; ++kt) {
        const int k0 = kt * 64; const int cur = kt & 1;
        const LAS h16* Ks = Ks0 + cur * 8704; const LAS h16* Vt = Vt0 + cur * 9216;
        if (kt + 1 < nkt) ATT_STAGE(cur ^ 1, 512 + h * 128, 1024 + h * 128, kt + 2);
        if (!(k0 > q0 + 31)) {
        f32x16 sc[2];
#pragma unroll
        for (int sub = 0; sub < 2; ++sub) {
#pragma unroll
            for (int i = 0; i < 16; ++i) sc[sub][i] = 0.f;
#pragma unroll
            for (int s = 0; s < 4; ++s) sc[sub] = mma32(*(const LAS h16x8*)(Ks + (32 * sub + r) * 136 + mp * 64 + 16 * s + 8 * hh), qf[s], sc[sub]);
        }
        float mx = -INFINITY;
        if (k0 + 63 + 128 <= q0) {
            const float bfar = bdl[128];
#pragma unroll
            for (int sub = 0; sub < 2; ++sub)
#pragma unroll
                for (int i = 0; i < 16; ++i) { sc[sub][i] += bfar; mx = fmaxf(mx, sc[sub][i]); }
        } else {
#pragma unroll
            for (int sub = 0; sub < 2; ++sub)
#pragma unroll
                for (int i = 0; i < 16; ++i) { const int kp = k0 + 32 * sub + (i & 3) + 8 * (i >> 2) + 4 * hh; const int dist = qp - kp;
                    const float v = dist < 0 ? -INFINITY : sc[sub][i] + bdl[dist < 128 ? dist : 128]; sc[sub][i] = v; mx = fmaxf(mx, v); }
        }
        mx = fmaxf(mx, __shfl_xor(mx, 32));
        const float m_new = fmaxf(m_run, mx);
        const float alpha = __builtin_amdgcn_exp2f(m_run - m_new);
        const bool resc = __ballot(m_new > m_run) != 0ull;
        float ls = 0.f;
#pragma unroll
        for (int sub = 0; sub < 2; ++sub)
#pragma unroll
            for (int i = 0; i < 16; ++i) { const float e = __builtin_amdgcn_exp2f(sc[sub][i] - m_new); sc[sub][i] = e; ls += e; }
        ls += __shfl_xor(ls, 32);
        l_run = l_run * alpha + ls; m_run = m_new;
        if (resc) {
#pragma unroll
            for (int d = 0; d < 4; ++d)
#pragma unroll
                for (int i = 0; i < 16; ++i) o[d][i] *= alpha;
        }
#pragma unroll
        for (int sub = 0; sub < 2; ++sub)
#pragma unroll
            for (int s2 = 0; s2 < 2; ++s2) {
                h16x8 pf;
#pragma unroll
                for (int jj = 0; jj < 8; ++jj) pf[jj] = (h16)sc[sub][8 * s2 + jj];
#pragma unroll
                for (int d = 0; d < 4; ++d) {
                    const int coff = 32 * d * 72 + ((((sub << 1) | s2) ^ d) << 4);
                    const h16x4 lo = *(const LAS h16x4*)(Vt + vlo + coff), hi = *(const LAS h16x4*)(Vt + vhi + coff);
                    h16x8 vf; vf[0] = lo[0]; vf[1] = lo[1]; vf[2] = lo[2]; vf[3] = lo[3]; vf[4] = hi[0]; vf[5] = hi[1]; vf[6] = hi[2]; vf[7] = hi[3];
                    o[d] = mma32(vf, pf, o[d]);
                }
            }
        }
        __syncthreads();
    }
    const float inv = 1.f / l_run;
    if (mp == 1) {
#pragma unroll
        for (int d = 0; d < 4; ++d)
#pragma unroll
            for (int i = 0; i < 16; ++i) Ox[(qs * 64 + d * 16 + i) * 64 + lane] = o[d][i] * inv;
    }
    __syncthreads();
    if (mp == 0) {
        const float lam = misc[j * 2], li = misc[j * 2 + 1];
        const float* sg = p.in[16] + j * 128;
        float ss = 0.f;
#pragma unroll
        for (int d = 0; d < 4; ++d)
#pragma unroll
            for (int i = 0; i < 16; ++i) { const float v = o[d][i] * inv - lam * Ox[(qs * 64 + d * 16 + i) * 64 + lane]; o[d][i] = v; ss += v * v; }
        ss += __shfl_xor(ss, 32);
        const float rs = rsqrtf(ss * (1.f / 128.f) + EPS) * (1.f - li);
#pragma unroll
        for (int d = 0; d < 4; ++d)
#pragma unroll
            for (int i = 0; i < 16; ++i) { const int dv = 32 * d + (i & 3) + 8 * (i >> 2) + 4 * hh;
                y[(size_t)(tb0 + q0 + r) * D + h * 128 + dv] = (h16)(o[d][i] * rs * sg[dv]); }
    }
}

constexpr size_t R_BM = (size_t)T * OD_N * 2;
__device__ __forceinline__ void dsa_select_item(CParams& p, LAS unsigned char* lds, int b, int qblk, int tid_in, int wave) {
    int tid = tid_in; asm volatile("" : "+v"(tid)); const int lane = tid & 63;
    unsigned char* R = p.ws + WS_R; const h16* proj = (const h16*)(R + R_PROJ);
    unsigned long long* bm = (unsigned long long*)(R + R_BM);
    float* scw = (float*)(R + R_SC) + (size_t)blockIdx.x * 32 * 4096;
    const int tb0 = b * SEQ; const int q0 = qblk * 32 + 4 * wave;
    {
        LAS h16* Aq = (LAS h16*)(lds + 40960);
        LAS float* Wq = (LAS float*)(lds + 77824);
        __syncthreads();
        {   const int Rr = tid >> 1, half = tid & 1, a = Rr >> 5, r = Rr & 31;
            const int rho = (r & 3) + 4 * (r >> 3), hd = rho & 7, qloc = 2 * ((r >> 2) & 1) + (rho >> 3);
            const h16* src = proj + (size_t)(tb0 + qblk * 32 + 4 * a + qloc) * OD_N + 2304 + hd * 64 + half * 32;
            h16x8 tq4[4]; h16 wv1 = (h16)0.f;
#pragma unroll
            for (int c = 0; c < 4; ++c) tq4[c] = *(const h16x8*)(src + c * 8);
            if (tid < 256) wv1 = proj[(size_t)(tb0 + qblk * 32 + (tid >> 3)) * OD_N + 2880 + (tid & 7)];
#pragma unroll
            for (int c = 0; c < 4; ++c) *(LAS h16x8*)(Aq + Rr * 72 + half * 32 + c * 8) = tq4[c];
            if (tid < 256) Wq[tid] = (float)wv1;
        }
        __syncthreads();
        const int r = lane & 31, hk = lane >> 5;
        const int nk32 = qblk + 1;
        const h16* kp0 = proj + (size_t)(tb0 + r) * OD_N + 2816 + 8 * hk;
        h16x8 bf[4], bn[4];
        if (wave < nk32) {
#pragma unroll
            for (int s = 0; s < 4; ++s) bf[s] = *(const h16x8*)(kp0 + (size_t)wave * 32 * OD_N + 16 * s);
        }
        for (int kt = wave; kt < nk32; kt += 8) {
            const int ktn = kt + 8 < nk32 ? kt + 8 : kt;
#pragma unroll
            for (int s = 0; s < 4; ++s) bn[s] = *(const h16x8*)(kp0 + (size_t)ktn * 32 * OD_N + 16 * s);
            const int kp = kt * 32 + r;
#pragma unroll 1
            for (int a = 0; a < 8; ++a) {
                f32x16 acc;
#pragma unroll
                for (int i = 0; i < 16; ++i) acc[i] = 0.f;
#pragma unroll
                for (int s = 0; s < 4; ++s) acc = mma32(*(const LAS h16x8*)(Aq + (32 * a + r) * 72 + 16 * s + 8 * hk), bf[s], acc);
#pragma unroll
                for (int qq = 0; qq < 2; ++qq) { const int qi = 4 * a + 2 * hk + qq;
                    const f32x4 w0 = *(const LAS f32x4*)(Wq + qi * 8), w1 = *(const LAS f32x4*)(Wq + qi * 8 + 4);
                    float sv = 0.f;
#pragma unroll
                    for (int e = 0; e < 4; ++e) { sv += w0[e] * fmaxf(acc[8 * qq + e], 0.f); sv += w1[e] * fmaxf(acc[8 * qq + 4 + e], 0.f); }
                    const int qpq = qblk * 32 + qi;
                    scw[(size_t)qi * 4096 + kp] = kp <= qpq ? sv : -INFINITY; }
            }
#pragma unroll
            for (int s = 0; s < 4; ++s) bf[s] = bn[s];
        }
        __syncthreads();
    }
#pragma unroll 1
    for (int ql = 0; ql < 4; ++ql) {
        const int qp = q0 + ql; const int tq = tb0 + qp;
        int lane2 = lane; asm volatile("" : "+v"(lane2));
        unsigned mlo, mhi;
        if (qp + 1 <= 256) {
            const int lo = lane2 * 64; const int nb = qp - lo + 1;
            const unsigned long long m = nb >= 64 ? ~0ull : (nb <= 0 ? 0ull : ((1ull << nb) - 1ull));
            mlo = (unsigned)m; mhi = (unsigned)(m >> 32);
        } else {
            unsigned u[64];
            const float* srow = scw + (size_t)(4 * wave + ql) * 4096 + lane2;
#pragma unroll
            for (int i = 0; i < 64; ++i) u[i] = __float_as_uint(srow[i * 64]);
            __builtin_amdgcn_sched_barrier(0);
#pragma unroll
            for (int i = 0; i < 64; ++i) { const int k = i * 64 + lane2; unsigned bb = u[i];
                if (bb == 0x80000000u) bb = 0u; bb = (bb & 0x80000000u) ? ~bb : (bb | 0x80000000u);
                u[i] = k <= qp ? bb : 0u; }
#define CNT_GE(cnt, x, c) do { int t_; asm volatile("v_cmp_ge_u32 vcc, %2, %3\n\ts_bcnt1_i32_b64 %1, vcc\n\ts_add_i32 %0, %0, %1" : "+s"(cnt), "=&s"(t_) : "v"(x), "v"(c) : "vcc", "scc"); } while (0)
#define CNT_GE4(cnt, x0, x1, x2, x3, c) do { int t_; unsigned long long m1_, m2_, m3_; asm volatile( \
                "v_cmp_ge_u32 vcc, %5, %9\n\tv_cmp_ge_u32_e64 %2, %6, %9\n\tv_cmp_ge_u32_e64 %3, %7, %9\n\tv_cmp_ge_u32_e64 %4, %8, %9\n\t" \
                "s_bcnt1_i32_b64 %1, vcc\n\ts_add_i32 %0, %0, %1\n\ts_bcnt1_i32_b64 %1, %2\n\ts_add_i32 %0, %0, %1\n\t" \
                "s_bcnt1_i32_b64 %1, %3\n\ts_add_i32 %0, %0, %1\n\ts_bcnt1_i32_b64 %1, %4\n\ts_add_i32 %0, %0, %1" \
                : "+s"(cnt), "=&s"(t_), "=&s"(m1_), "=&s"(m2_), "=&s"(m3_) : "v"(x0), "v"(x1), "v"(x2), "v"(x3), "v"(c) : "vcc", "scc"); } while (0)
            const int nreg = __builtin_amdgcn_readfirstlane((qp >> 6) + 1);
            unsigned thr = 0u;
            for (int bit = 31; bit >= 0; --bit) {
                const unsigned cand = thr | (1u << bit); int c = 0;
#pragma unroll
                for (int i = 0; i < 64; i += 4) if (i < nreg) CNT_GE4(c, u[i], u[i + 1], u[i + 2], u[i + 3], cand);
                if (c >= 256) thr = cand;
                if (c == 256) break;
            }
            int cge = 0, cgt = 0; const unsigned thr1 = thr + 1u;
#pragma unroll
            for (int i = 0; i < 64; ++i) { CNT_GE(cge, u[i], thr); CNT_GE(cgt, u[i], thr1); }
            const int need_eq = 256 - cgt, ceq = cge - cgt;
#pragma unroll
            for (int i = 0; i < 64; ++i) { const unsigned t1 = (unsigned)(i * 64 + lane2 + 1); unsigned rr;
                asm volatile("v_cmp_eq_u32 vcc, %1, %2\n\tv_cndmask_b32 %0, -1, %3, vcc\n\tv_cmp_gt_u32 vcc, %1, %2\n\tv_cndmask_b32_e64 %0, %0, 0, vcc" : "=&v"(rr) : "v"(u[i]), "v"(thr), "v"(t1) : "vcc");
                u[i] = rr; }
            int kcut = 0;
            if (ceq == need_eq) kcut = 4095;
            else {
                for (int bit = 11; bit >= 0; --bit) {
                    const unsigned test2 = (unsigned)(kcut + (1 << bit) - 1) + 2u; int c = 0;
#pragma unroll
                    for (int i = 0; i < 64; i += 4) CNT_GE4(c, u[i], u[i + 1], u[i + 2], u[i + 3], test2);
                    const int ties_le = (4096 - c) - cgt;
                    if (ties_le < need_eq) kcut += (1 << bit);
                }
            }
#undef CNT_GE
#undef CNT_GE4
            const unsigned kc1 = (unsigned)kcut + 1u;
            mlo = 0u; mhi = 0u;
#pragma unroll
            for (int i = 0; i < 64; ++i)
                asm volatile("v_cmp_le_u32 vcc, %2, %3\n\ts_nop 4\n\tv_writelane_b32 %0, vcc_lo, %4\n\tv_writelane_b32 %1, vcc_hi, %4" : "+v"(mlo), "+v"(mhi) : "v"(u[i]), "v"(kc1), "n"(i) : "vcc");
        }
        bm[(size_t)tq * 64 + lane2] = ((unsigned long long)mhi << 32) | mlo;
    }
}

__device__ __forceinline__ void dsa_attn_item(CParams& p, LAS unsigned char* lds, int b, int qb, int tid_in, int wave) {
    int tid = tid_in; asm volatile("" : "+v"(tid)); const int lane = tid & 63;
    unsigned char* R = p.ws + WS_R; const h16* proj = (const h16*)(R + R_PROJ); h16* y = (h16*)(R + R_Y);
    const unsigned long long* bm = (const unsigned long long*)(R + R_BM);
    const float* bd = (const float*)(p.ws + WS_BIASD) + 4 * 132;
    LAS h16* Ks0 = (LAS h16*)lds;
    LAS h16* Vt0 = (LAS h16*)(lds + 34816);
    LAS float* bdl = (LAS float*)(lds + 71680);
    const int hd = wave & 3, qs = wave >> 2, r = lane & 31, hh = lane >> 5;
    const int tb0 = b * SEQ; const int q0 = qb * 64 + 32 * qs;
    for (int i = tid; i < 4 * 132; i += NTHREADS) bdl[i] = bd[i];
    h16x8 qf[8];
#pragma unroll
    for (int s = 0; s < 8; ++s) qf[s] = *(const h16x8*)(proj + (size_t)(tb0 + q0 + r) * OD_N + 1536 + hd * 128 + 16 * s + 8 * hh);
    f32x16 o[4];
#pragma unroll
    for (int d = 0; d < 4; ++d)
#pragma unroll
        for (int i = 0; i < 16; ++i) o[d][i] = 0.f;
    float m_run = -INFINITY, l_run = 0.f;
    const int qp = q0 + r;
    const int vlo = r * 72 + ((hh ^ (r >> 3)) << 2), vhi = r * 72 + (((hh ^ (r >> 3)) ^ 2) << 2);
    const unsigned long long* bmq = bm + (size_t)(tb0 + qp) * 64;
    const LAS float* bdh = bdl + hd * 132;
    const int nkt = qb + 1;
    h16x8 pk[2], pv[2];
#pragma unroll
    for (int i = 0; i < 2; ++i) { const int key = i * 32 + (tid >> 4), ch = tid & 15;
        pk[i] = *(const h16x8*)(proj + (size_t)(tb0 + key) * OD_N + 2048 + ch * 8);
        pv[i] = *(const h16x8*)(proj + (size_t)(tb0 + key) * OD_N + 2176 + ch * 8); }
    ATT_STAGE(0, 2048, 2176, 1);
    unsigned long long mkn = bmq[0];
    __syncthreads();
    for (int kt = 0; kt < nkt; ++kt) {
        const int k0 = kt * 64; const int cur = kt & 1;
        const LAS h16* Ks = Ks0 + cur * 8704; const LAS h16* Vt = Vt0 + cur * 9216;
        const unsigned long long mk = mkn; mkn = bmq[kt + 1 < nkt ? kt + 1 : kt];
        if (kt + 1 < nkt) ATT_STAGE(cur ^ 1, 2048, 2176, kt + 2);
        if (__ballot(mk != 0ull) != 0ull) {
            const bool far = (k0 + 63 + 128 <= q0);
            const float bfar = bdh[128];
#pragma unroll
            for (int sub = 0; sub < 2; ++sub) {
                const unsigned mw = (unsigned)(mk >> (32 * sub));
                if (__ballot(mw != 0u) == 0ull) continue;
                f32x16 sc;
#pragma unroll
                for (int i = 0; i < 16; ++i) sc[i] = 0.f;
#pragma unroll
                for (int s = 0; s < 8; ++s) sc = mma32(*(const LAS h16x8*)(Ks + (32 * sub + r) * 136 + 16 * s + 8 * hh), qf[s], sc);
                float mx = -INFINITY;
#pragma unroll
                for (int i = 0; i < 16; ++i) { const int ko = (i & 3) + 8 * (i >> 2) + 4 * hh; const int dist = qp - (k0 + 32 * sub + ko);
                    float bias = bfar; if (!far) bias = bdh[dist < 0 ? 0 : (dist < 128 ? dist : 128)];
                    const float v = ((mw >> ko) & 1u) ? sc[i] + bias : -INFINITY; sc[i] = v; mx = fmaxf(mx, v); }
                mx = fmaxf(mx, __shfl_xor(mx, 32));
                const float m_new = fmaxf(m_run, mx);
                const float msafe = (m_new == -INFINITY) ? 0.f : m_new;
                const float alpha = __builtin_amdgcn_exp2f(m_run - msafe);
                const bool resc = __ballot(m_new > m_run) != 0ull;
                float ls = 0.f;
#pragma unroll
                for (int i = 0; i < 16; ++i) { const float e = __builtin_amdgcn_exp2f(sc[i] - msafe); sc[i] = e; ls += e; }
                ls += __shfl_xor(ls, 32);
                l_run = l_run * alpha + ls; m_run = m_new;
                if (resc) {
#pragma unroll
                    for (int d = 0; d < 4; ++d)
#pragma unroll
                        for (int i = 0; i < 16; ++i) o[d][i] *= alpha;
                }
#pragma unroll
                for (int s2 = 0; s2 < 2; ++s2) {
                    h16x8 pf;
#pragma unroll
                    for (int jj = 0; jj < 8; ++jj) pf[jj] = (h16)sc[8 * s2 + jj];
#pragma unroll
                    for (int d = 0; d < 4; ++d) {
                        const int coff = 32 * d * 72 + ((((sub << 1) | s2) ^ d) << 4);
                        const h16x4 lo = *(const LAS h16x4*)(Vt + vlo + coff), hi = *(const LAS h16x4*)(Vt + vhi + coff);
                        h16x8 vf; vf[0] = lo[0]; vf[1] = lo[1]; vf[2] = lo[2]; vf[3] = lo[3]; vf[4] = hi[0]; vf[5] = hi[1]; vf[6] = hi[2]; vf[7] = hi[3];
                        o[d] = mma32(vf, pf, o[d]);
                    }
                }
            }
        }
        __syncthreads();
    }
#undef ATT_STAGE
    const float inv = 1.f / l_run;
#pragma unroll
    for (int d = 0; d < 4; ++d)
#pragma unroll
        for (int i = 0; i < 16; ++i) { const int dv = 32 * d + (i & 3) + 8 * (i >> 2) + 4 * hh;
            y[(size_t)(tb0 + q0 + r) * D + 512 + hd * 128 + dv] = (h16)(o[d][i] * inv); }
}

__device__ __forceinline__ void phase_odd_attn(const int wid_s, CParams& p, int j, int layer, LAS unsigned char* lds) {
    int tid_ = TIDX; asm volatile("" : "+v"(tid_));
    const int tid = tid_, lane = tid & 63, wave = tid >> 6;
    for (int w = blockIdx.x; w < 256; w += gridDim.x) {
        const int xcd = w & 7, kx = w >> 3;
        {
#pragma unroll 1
            for (int i = 0; i < 4; ++i) { const int b = xcd + 8 * (i >> 1); const int qb = (i & 1) ? (63 - kx) : kx;
                dsa_select_item(p, lds, b, 2 * qb, tid, wave); dsa_select_item(p, lds, b, 2 * qb + 1, tid, wave);
                __syncthreads();
                dsa_attn_item(p, lds, b, qb, tid, wave);
                __syncthreads(); }
        }
        __syncthreads();
        {
#pragma unroll 1
            for (int i = 0; i < 8; ++i) { const int bh = xcd * 8 + i, b = bh >> 2, h = bh & 3; const int base = (kx + 8 * (i >> 1)) & 31; const int qb = (i & 1) ? (31 - base) : base;
                diff_attn_item(p, j, layer, lds, b, h, qb, tid, lane, wave); __syncthreads(); }
        }
    }
}

__device__ __forceinline__ void grid_barrier(unsigned* ctr, unsigned gen, const int wid_s) {
    __syncthreads();
    if (TIDX == 0) {
        __builtin_amdgcn_fence(__ATOMIC_RELEASE, "agent");
        asm volatile("s_waitcnt vmcnt(0)" ::: "memory");
        const unsigned target = gen * gridDim.x;
        __hip_atomic_fetch_add(ctr, 1u, __ATOMIC_RELAXED, __HIP_MEMORY_SCOPE_AGENT);
        unsigned spins = 0;
        while (__hip_atomic_load(ctr, __ATOMIC_RELAXED, __HIP_MEMORY_SCOPE_AGENT) < target) { __builtin_amdgcn_s_sleep(1); if (++spins > (1u << 24)) break; }
        __builtin_amdgcn_fence(__ATOMIC_ACQUIRE, "agent");
        asm volatile("s_waitcnt vmcnt(0)" ::: "memory");
    }
    __syncthreads();
}

__global__ void __launch_bounds__(NTHREADS, 2) mk_fwd(Params p_unused) {
    extern __shared__ __attribute__((aligned(16))) unsigned char lds_raw[];
    LAS unsigned char* lds = (LAS unsigned char*)lds_raw;
    cg::grid_group grid = cg::this_grid();
    const int wid_s = __builtin_amdgcn_readfirstlane((int)(threadIdx.x >> 6));
    int ph = 0;
    const int ph_lo = launder_kp()->ph_lo, ph_hi = launder_kp()->ph_hi;
#define PHASE_BEGIN if (ph >= ph_lo && ph < ph_hi) { CParams& p = *launder_kp(); unsigned char* ws = p.ws; h16* hb = (h16*)(ws + WS_HB); float* rsq = (float*)(ws + WS_RSQ); unsigned char* R = ws + WS_R; (void)hb; (void)rsq; (void)R;
#define PHASE_END   if (ph + 1 < ph_hi) { if (ph == 0) grid.sync(); else grid_barrier((unsigned*)(launder_kp()->ws + WS_MISC + 128), (unsigned)ph, wid_s); } } ++ph;

    PHASE_BEGIN phase_prep(wid_s, p, lds); PHASE_END

    for (int l = 0; l < DEPTH; ++l) {
        const int j = l >> 1;
        if ((l & 1) == 0) {
            PHASE_BEGIN {
                pg8::Gemm g{hb, (const h16*)(ws + WS_WIN_E + j * SZ_WIN_E), T, EV_N, D, D}; pg8::StaticOrder S; S.init(T, EV_N, gridDim.x, blockIdx.x);
                pg8::EpiStoreH E{(h16*)(R + R_PROJ), EV_N, rsq + (size_t)(2 * l) * T, 4, 12, (float*)(ws + WS_BA), nullptr};
                pg8::gemm_phase<pg8::EpiStoreH>(lds, g, S, E, wid_s);
            } PHASE_END
            PHASE_BEGIN phase_even_mix(wid_s, p, j, lds); PHASE_END
            PHASE_BEGIN phase_gdn_scan(wid_s, p, lds); PHASE_END
            PHASE_BEGIN phase_gdn_gate(wid_s, p, j); PHASE_END
            PHASE_BEGIN {
                pg8::Gemm g{(const h16*)(R + R_Y), (const h16*)(ws + WS_WOUT + l * SZ_WOUT), T, D, D, D}; pg8::StaticOrder S; S.init(T, D, gridDim.x, blockIdx.x);
                pg8::EpiResid E{p.out, hb, rsq + (size_t)(2 * l + 1) * T};
                pg8::gemm_phase<pg8::EpiResid>(lds, g, S, E, wid_s);
            } PHASE_END
        } else {
            PHASE_BEGIN {
                pg8::Gemm g{hb, (const h16*)(ws + WS_WIN_O + j * SZ_WIN_O), T, OD_N, D, D}; pg8::StaticOrder S; S.init(T, OD_N, gridDim.x, blockIdx.x);
                pg8::EpiOddIn E{(h16*)(R + R_PROJ), OD_N, rsq + (size_t)(2 * l) * T, (const float*)(ws + WS_GTAB) + j * 512, (LAS float*)(lds + 131072)};
                pg8::gemm_phase<pg8::EpiOddIn>(lds, g, S, E, wid_s);
            } PHASE_END
            PHASE_BEGIN phase_odd_attn(wid_s, p, j, l, lds); PHASE_END
            PHASE_BEGIN {
                pg8::Gemm g{(const h16*)(R + R_Y), (const h16*)(ws + WS_WOUT + l * SZ_WOUT), T, D, D, D}; pg8::StaticOrder S; S.init(T, D, gridDim.x, blockIdx.x);
                pg8::EpiResid E{p.out, hb, rsq + (size_t)(2 * l + 1) * T};
                pg8::gemm_phase<pg8::EpiResid>(lds, g, S, E, wid_s);
            } PHASE_END
        }
        PHASE_BEGIN {
            pg8::Gemm g{hb, (const h16*)(ws + WS_WUP + l * SZ_WUP), T, FF2, D, D}; pg8::StaticOrder S; S.init(T, FF2, gridDim.x, blockIdx.x);
            pg8::EpiUpFused E{(h16*)R, rsq + (size_t)(2 * l + 1) * T, p.in[21] + (size_t)l * 3 * FF2, p.in[22] + (size_t)l * FF2, (h16*)(ws + WS_HALO), (LAS float*)(lds + 131072)};
            pg8::gemm_phase<pg8::EpiUpFused>(lds, g, S, E, wid_s);
        } PHASE_END
        PHASE_BEGIN phase_ffn_fixup(wid_s, (h16*)R, (const h16*)(ws + WS_HALO), p.in[21] + (size_t)l * 3 * FF2, p.in[22] + (size_t)l * FF2); PHASE_END
        PHASE_BEGIN {
            pg8::Gemm g{(const h16*)R, (const h16*)(ws + WS_WDN + l * SZ_WDN), T, D, FF, FF}; pg8::StaticOrder S; S.init(T, D, gridDim.x, blockIdx.x);
            pg8::EpiResid E{p.out, hb, rsq + (size_t)(2 * l + 2) * T};
            pg8::gemm_phase<pg8::EpiResid>(lds, g, S, E, wid_s);
        } PHASE_END
    }
}

extern "C" void kernel_launch(void* const* d_in, const int* in_sizes, int n_in, void* d_out, int out_size, void* d_ws, size_t ws_size, hipStream_t stream) {
    static int grid_blocks = 0;
    if (grid_blocks == 0) {
        if (ws_size < WS_END) { fprintf(stderr, "kernel_launch: workspace too small: %zu < %zu\n", ws_size, (size_t)WS_END); grid_blocks = -1; return; }
        int dev = 0, cus = 0, per_cu = 0;
        hipGetDevice(&dev);
        hipDeviceGetAttribute(&cus, hipDeviceAttributeMultiprocessorCount, dev);
        if (hipFuncSetAttribute((const void*)mk_fwd, hipFuncAttributeMaxDynamicSharedMemorySize, LDS_BYTES) != hipSuccess) { fprintf(stderr, "kernel_launch: hipFuncSetAttribute failed\n"); grid_blocks = -1; return; }
        hipOccupancyMaxActiveBlocksPerMultiprocessor(&per_cu, (const void*)mk_fwd, NTHREADS, LDS_BYTES);
        if (per_cu < 1) per_cu = 1;
        grid_blocks = cus * 1;
        fprintf(stderr, "kernel_launch: cus %d per_cu %d grid %d ws %zu need %zu\n", cus, per_cu, grid_blocks, ws_size, (size_t)WS_END);
    }
    if (grid_blocks < 0) return;
    if (hipMemsetAsync((char*)d_ws + WS_MISC + 128, 0, 64, stream) != hipSuccess) { fprintf(stderr, "kernel_launch: memset failed\n"); return; }
    Params p{};
    for (int i = 0; i < 24; ++i) p.in[i] = (const float*)d_in[i];
    p.out = (float*)d_out; p.ws = (unsigned char*)d_ws; p.ph_lo = 0; p.ph_hi = 1000;
    void* args[] = {&p};
    hipError_t e = hipLaunchCooperativeKernel((const void*)mk_fwd, dim3(grid_blocks), dim3(NTHREADS), args, LDS_BYTES, stream);
    if (e != hipSuccess) fprintf(stderr, "cooperative launch failed: %s (grid %d)\n", hipGetErrorString(e), grid_blocks);
}
```

```cpp
#include <hip/hip_runtime.h>
#include <hip/hip_cooperative_groups.h>
#include <cstdio>
namespace cg = cooperative_groups;

#define LAS __attribute__((address_space(3)))
typedef _Float16 h16;
typedef _Float16 h16x2 __attribute__((ext_vector_type(2)));
typedef _Float16 h16x4 __attribute__((ext_vector_type(4)));
typedef _Float16 h16x8 __attribute__((ext_vector_type(8)));
typedef float f32x2 __attribute__((ext_vector_type(2)));
typedef float f32x4 __attribute__((ext_vector_type(4)));
typedef float f32x16 __attribute__((ext_vector_type(16)));
typedef unsigned u32x4 __attribute__((ext_vector_type(4)));
typedef unsigned u32x2 __attribute__((ext_vector_type(2)));

constexpr int T = 65536, D = 1024, SEQ = 4096, NBATCH = 16, DEPTH = 4;
constexpr int EV_N = 3328, EV_SRC = 3080, OD_N = 3072, OD_SRC = 2888, FF = 2816, FF2 = 5632;
constexpr float EPS = 1e-6f;
constexpr int NTHREADS = 512;
constexpr int LDS_BYTES = 147456;

constexpr size_t SZ_WIN_E = (size_t)EV_N * D * 2, SZ_WIN_O = (size_t)OD_N * D * 2, SZ_WOUT = (size_t)D * D * 2, SZ_WUP = (size_t)FF2 * D * 2, SZ_WDN = (size_t)D * FF * 2;
constexpr size_t WS_WIN_E = 0;
constexpr size_t WS_WIN_O = WS_WIN_E + 2 * SZ_WIN_E;
constexpr size_t WS_WOUT = WS_WIN_O + 2 * SZ_WIN_O;
constexpr size_t WS_WUP = WS_WOUT + 4 * SZ_WOUT;
constexpr size_t WS_WDN = WS_WUP + 4 * SZ_WUP;
constexpr size_t WS_HB = WS_WDN + 4 * SZ_WDN;
constexpr size_t WS_RSQ = WS_HB + (size_t)T * D * 2;
constexpr size_t WS_BA = WS_RSQ + (size_t)9 * T * 4;
constexpr size_t WS_GWS = WS_BA + (size_t)T * 8 * 4;
constexpr size_t WS_BIASD = WS_GWS + (size_t)2 * 4 * 128 * 128 * 2;
constexpr size_t WS_MISC = WS_BIASD + 8 * 132 * 4;
constexpr size_t WS_GCL = WS_MISC + 256;
constexpr size_t WS_GTAB = WS_GCL + (size_t)(T / 64) * 4 * 4;
constexpr size_t WS_HALO = WS_GTAB + 2 * 4 * 128 * 4;
constexpr size_t WS_R = WS_HALO + (size_t)(T / 64) * 2 * FF2 * 2;
constexpr size_t R_PROJ = 0;
constexpr size_t R_Y = (size_t)T * EV_N * 2;
constexpr size_t R_G = R_Y + (size_t)T * D * 2;
constexpr size_t R_QG = R_G, R_KDT = R_G + (size_t)T * 512 * 2, R_INTRA = R_KDT + (size_t)T * 512 * 2;
constexpr size_t R_END = (size_t)T * FF2 * 2;
constexpr size_t WS_END = WS_R + R_END;

struct Params {
    const float* in[24];
    float* out;
    unsigned char* ws;
    int ph_lo, ph_hi;
};

typedef const __attribute__((address_space(4))) Params CParams;
__device__ __forceinline__ CParams* launder_kp() { CParams* q = (CParams*)__builtin_amdgcn_kernarg_segment_ptr(); asm volatile("" : "+s"(q)); return q; }

__device__ __forceinline__ int opaque_bid() { int b = blockIdx.x; asm volatile("" : "+v"(b)); return __builtin_amdgcn_readfirstlane(b); }

__device__ __forceinline__ int hw_lane() { return (int)__builtin_amdgcn_mbcnt_hi(~0u, __builtin_amdgcn_mbcnt_lo(~0u, 0u)); }
#define TIDX (wid_s * 64 + hw_lane())

__device__ __forceinline__ float wave_sum(float v) {
#pragma unroll
    for (int o = 32; o > 0; o >>= 1) v += __shfl_xor(v, o);
    return v;
}
__device__ __forceinline__ float gelu_tanh(float x) { const float z = 1.5957691216f * (x + 0.044715f * x * x * x); return x * __builtin_amdgcn_rcpf(1.f + __expf(-z)); }
__device__ __forceinline__ float silu_f(float x) { return x * __builtin_amdgcn_rcpf(1.f + __expf(-x)); }
__device__ __forceinline__ u32x4 pack8(const f32x4 a, const f32x4 b) {
    h16x8 h; h[0] = (h16)a[0]; h[1] = (h16)a[1]; h[2] = (h16)a[2]; h[3] = (h16)a[3]; h[4] = (h16)b[0]; h[5] = (h16)b[1]; h[6] = (h16)b[2]; h[7] = (h16)b[3];
    return __builtin_bit_cast(u32x4, h);
}

namespace pg8 {
constexpr int BM = 256, BK = 64, HALF = 128, HTB = HALF * BK * 2, STAGE_BYTES = 8 * HTB, NXCD = 8, WGM = 8;
__device__ __forceinline__ int lds_byte(int r, int c) { const int st = (r >> 4) * 2 + (c >> 5), rr = r & 15, cc = c & 31, ob = rr * 64 + cc * 2; return st * 1024 + (ob ^ (((ob >> 9) & 1) << 5)); }
__device__ __forceinline__ void stage_rc(int b, int& R, int& C) { const int st = b / 1024, sb = b % 1024, swz = sb ^ (((sb >> 9) & 1) << 5); R = (st >> 1) * 16 + swz / 64; C = (st & 1) * 32 + (swz % 64) / 2; }
__device__ __forceinline__ int perm32(int rho) { const int n = rho >> 4, i = rho & 15; return 8 * (i >> 2) + 4 * n + (i & 3); }
struct Unit { int pm, pn; };
struct Gemm { const h16* A; const h16* Bt; int M, N, K, lda; };
struct StaticOrder {
    int nM, nN, nwg, G, c;
    __device__ void init(int M, int N, int G_, int c_) { nM = M / BM; nN = N / BM; nwg = nM * nN; G = G_; c = c_; }
    __device__ bool next(int i, Unit& u) const {
        const long L = (long)i * G + c; if (L >= nwg) return false;
        int wgid = (int)L; { const int q = nwg / NXCD, r = nwg % NXCD, xcd = wgid % NXCD, off = wgid / NXCD; wgid = (xcd < r ? xcd * (q + 1) : r * (q + 1) + (xcd - r) * q) + off; }
        const int nig = WGM * nN, gid = wgid / nig, fm = gid * WGM, gsz = (nM - fm) < WGM ? (nM - fm) : WGM;
        u.pm = fm + ((wgid % nig) % gsz); u.pn = (wgid % nig) / gsz; return true;
    }
};

template <class Epi>
__device__ __forceinline__ void gemm_phase(LAS unsigned char* lds, const Gemm g, const StaticOrder& S, const Epi& E, const int wid_s) {
    int tid_ = TIDX; asm volatile("" : "+v"(tid_));
    const int tid = tid_, wid = __builtin_amdgcn_readfirstlane(tid >> 6), lane = tid & 63, wr = wid >> 2, wc = wid & 3, fr = lane & 15, fq = lane >> 4;
    const int K = g.K, nt = K / BK, lda = g.lda;
    unsigned voffA[2], voffB[2];
#pragma unroll
    for (int i = 0; i < 2; ++i) { int R, C; stage_rc(tid * 16 + i * 8192, R, C); const int Rb = Epi::PERM ? ((R & ~31) + perm32(R & 31)) : R;
        voffA[i] = (unsigned)(R * lda + C) * 2u; voffB[i] = (unsigned)(Rb * K + C) * 2u; }
    const size_t kstep = (size_t)(BK * 2);
    const size_t hstepA = (size_t)HALF * lda * 2, hstepB = (size_t)HALF * K * 2;
    const size_t tstepA = 2 * hstepA, tstepB = 2 * hstepB;
    const unsigned ldsw = (unsigned)wid * 1024u;
    const int aoff = lds_byte(wr * 64 + fr, fq * 8), boff = lds_byte(wc * 32 + fr, fq * 8);
#define PG8_SA(b, h) (((b) * 2 + (h)) * HTB)
#define PG8_SB(b, h) ((4 + (b) * 2 + (h)) * HTB)
#define PG8_STAGE(bufoff, gbase, voff) do { _Pragma("unroll") for (int _i = 0; _i < 2; ++_i) \
        __builtin_amdgcn_global_load_lds((const unsigned*)((const char*)(gbase) + (voff)[_i]), (LAS unsigned*)(lds + (bufoff) + ldsw + _i * 8192), 16, 0, 0); } while (0)
#define PG8_LDA(dst, b, h) do { _Pragma("unroll") for (int m = 0; m < 4; ++m) _Pragma("unroll") for (int k = 0; k < 2; ++k) dst[m][k] = *(const LAS h16x8*)(lds + PG8_SA(b, h) + aoff + m * 2048 + k * 1024); } while (0)
#define PG8_LDB(dst, b, h) do { _Pragma("unroll") for (int n = 0; n < 2; ++n) _Pragma("unroll") for (int k = 0; k < 2; ++k) dst[n][k] = *(const LAS h16x8*)(lds + PG8_SB(b, h) + boff + n * 2048 + k * 1024); } while (0)
#define PG8_MMA(ai, bj, At, Bt) do { __builtin_amdgcn_s_setprio(1); _Pragma("unroll") for (int m = 0; m < 4; ++m) _Pragma("unroll") for (int n = 0; n < 2; ++n) _Pragma("unroll") for (int k = 0; k < 2; ++k) \
        acc[ai][bj][m][n] = __builtin_amdgcn_mfma_f32_16x16x32_f16(Bt[n][k], At[m][k], acc[ai][bj][m][n], 0, 0, 0); __builtin_amdgcn_s_setprio(0); } while (0)
#define PG8_WAIT_V(n) asm volatile("s_waitcnt vmcnt(" #n ")" ::: "memory")
#define PG8_WAIT_L(n) asm volatile("s_waitcnt lgkmcnt(" #n ")" ::: "memory")
#define PG8_BAR __builtin_amdgcn_s_barrier()
#define PG8_SCHED __builtin_amdgcn_sched_barrier(0)
    Unit cur, nxt; int ui = 0;
    if (!S.next(0, cur)) return;
    f32x4 acc[2][2][4][2];
#pragma unroll
    for (int a = 0; a < 2; ++a)
#pragma unroll
        for (int b = 0; b < 2; ++b)
#pragma unroll
            for (int m = 0; m < 4; ++m)
#pragma unroll
                for (int n = 0; n < 2; ++n) acc[a][b][m][n] = (f32x4){0.f, 0.f, 0.f, 0.f};
    h16x8 At[4][2], B0[2][2], B1[2][2];
    const char* cA = (const char*)g.A + (size_t)cur.pm * tstepA; const char* cB = (const char*)g.Bt + (size_t)cur.pn * tstepB;
    PG8_STAGE(PG8_SB(0, 0), cB, voffB); PG8_STAGE(PG8_SA(0, 0), cA, voffA); PG8_STAGE(PG8_SB(0, 1), cB + hstepB, voffB); PG8_STAGE(PG8_SA(0, 1), cA + hstepA, voffA);
    if (wr == 1) PG8_BAR;
    PG8_WAIT_V(4); PG8_BAR;
    PG8_STAGE(PG8_SB(1, 0), cB + kstep, voffB); PG8_STAGE(PG8_SA(1, 0), cA + kstep, voffA); PG8_STAGE(PG8_SB(1, 1), cB + hstepB + kstep, voffB);
    PG8_WAIT_V(6); PG8_BAR;
    for (;;) {
        const bool has_next = S.next(ui + 1, nxt);
        const char* nA = has_next ? (const char*)g.A + (size_t)nxt.pm * tstepA : cA; const char* nB = has_next ? (const char*)g.Bt + (size_t)nxt.pn * tstepB : cB;
        for (int t = 0; t < nt; t += 2) {
            const bool last = (t == nt - 2);
            const char* a1 = cA + (size_t)(t + 1) * kstep;
            const char* a2 = last ? nA : cA + (size_t)(t + 2) * kstep; const char* b2 = last ? nB : cB + (size_t)(t + 2) * kstep;
            const char* a3 = a2 + kstep; const char* b3 = b2 + kstep;
            PG8_LDB(B0, 0, 0); PG8_SCHED; PG8_LDA(At, 0, 0); PG8_STAGE(PG8_SA(1, 1), a1 + hstepA, voffA);
            PG8_WAIT_L(8); PG8_BAR; PG8_WAIT_L(0); PG8_MMA(0, 0, At, B0); PG8_BAR; PG8_SCHED;
            PG8_LDB(B1, 0, 1); PG8_STAGE(PG8_SB(0, 0), b2, voffB);
            PG8_BAR; PG8_WAIT_L(0); PG8_MMA(0, 1, At, B1); PG8_BAR;
            PG8_LDA(At, 0, 1); PG8_STAGE(PG8_SA(0, 0), a2, voffA);
            PG8_BAR; PG8_WAIT_L(0); PG8_MMA(1, 0, At, B0); PG8_BAR; PG8_SCHED;
            PG8_STAGE(PG8_SB(0, 1), b2 + hstepB, voffB);
            PG8_WAIT_V(6); PG8_BAR; PG8_MMA(1, 1, At, B1); PG8_BAR;
            PG8_LDB(B0, 1, 0); PG8_SCHED; PG8_LDA(At, 1, 0); PG8_STAGE(PG8_SA(0, 1), a2 + hstepA, voffA);
            PG8_WAIT_L(8); PG8_BAR; PG8_WAIT_L(0); PG8_MMA(0, 0, At, B0); PG8_BAR; PG8_SCHED;
            PG8_LDB(B1, 1, 1); PG8_STAGE(PG8_SB(1, 0), b3, voffB);
            PG8_BAR; PG8_WAIT_L(0); PG8_MMA(0, 1, At, B1); PG8_BAR;
            PG8_LDA(At, 1, 1); PG8_STAGE(PG8_SA(1, 0), a3, voffA);
            PG8_BAR; PG8_WAIT_L(0); PG8_MMA(1, 0, At, B0); PG8_BAR; PG8_SCHED;
            PG8_STAGE(PG8_SB(1, 1), b3 + hstepB, voffB);
            PG8_WAIT_V(6); PG8_BAR; PG8_MMA(1, 1, At, B1); PG8_BAR;
        }
        E(acc, cur, wr, wc, fr, fq);
        if (!has_next) break;
#pragma unroll
        for (int a = 0; a < 2; ++a)
#pragma unroll
            for (int b = 0; b < 2; ++b)
#pragma unroll
                for (int m = 0; m < 4; ++m)
#pragma unroll
                    for (int n = 0; n < 2; ++n) acc[a][b][m][n] = (f32x4){0.f, 0.f, 0.f, 0.f};
        cur = nxt; cA = nA; cB = nB; ++ui;
    }
    PG8_WAIT_V(0);
    if (wr == 0) PG8_BAR;
    PG8_BAR;
#undef PG8_SA
#undef PG8_SB
#undef PG8_STAGE
#undef PG8_LDA
#undef PG8_LDB
#undef PG8_MMA
#undef PG8_WAIT_V
#undef PG8_WAIT_L
#undef PG8_BAR
#undef PG8_SCHED
}

struct EpiStoreH {
    static constexpr bool PERM = true;
    h16* O; int ldc; const float* rowsq; int gelu_tiles; int ba_tile; float* ba; h16* halo;
    __device__ __forceinline__ void operator()(const f32x4 (&acc)[2][2][4][2], const Unit& u, int wr, int wc, int fr, int fq) const {
        const int row0 = u.pm * BM + wr * 64 + fr, col0 = u.pn * BM + wc * 32 + 8 * fq;
        const bool dg = u.pn < gelu_tiles, isba = (u.pn == ba_tile);
        float rsv[2][4];
#pragma unroll
        for (int ai = 0; ai < 2; ++ai)
#pragma unroll
            for (int m = 0; m < 4; ++m) rsv[ai][m] = rowsq[row0 + ai * HALF + m * 16];
#pragma unroll
        for (int ai = 0; ai < 2; ++ai)
#pragma unroll
            for (int m = 0; m < 4; ++m) {
                const int r = row0 + ai * HALF + m * 16;
                const float rs = rsqrtf(rsv[ai][m] * (1.0f / 1024.0f) + EPS);
#pragma unroll
                for (int bj = 0; bj < 2; ++bj) {
                    f32x4 v0 = acc[ai][bj][m][0] * rs, v1 = acc[ai][bj][m][1] * rs;
                    if (isba) {
                        if (bj == 0 && wc == 0 && fq == 0) { *(f32x4*)(ba + (size_t)r * 8) = v0; *(f32x4*)(ba + (size_t)r * 8 + 4) = v1; }
                    } else {
                        if (dg) {
#pragma unroll
                            for (int j = 0; j < 4; ++j) { v0[j] = gelu_tanh(v0[j]); v1[j] = gelu_tanh(v1[j]); }
                        }
                        const u32x4 w = pack8(v0, v1);
                        *(u32x4*)(O + (size_t)r * ldc + col0 + bj * HALF) = w;
                        if (halo != nullptr && m == 3 && fr >= 14) *(u32x4*)(halo + ((size_t)(r >> 6) * 2 + (fr - 14)) * ldc + col0 + bj * HALF) = w;
                    }
                }
            }
    }
};
struct EpiResid {
    static constexpr bool PERM = false;
    h16* HB; float* rsq_next; float* OUT;
    __device__ __forceinline__ void operator()(const f32x4 (&acc)[2][2][4][2], const Unit& u, int wr, int wc, int fr, int fq) const {
        const int row0 = u.pm * BM + wr * 64 + fr, col0 = u.pn * BM + wc * 32 + 4 * fq;
        h16x4 hin[2][2], hnx[2][2];
#pragma unroll
        for (int bj = 0; bj < 2; ++bj)
#pragma unroll
            for (int n = 0; n < 2; ++n) hin[bj][n] = *(const h16x4*)(HB + (size_t)row0 * D + col0 + bj * HALF + n * 16);
#pragma unroll
        for (int g = 0; g < 8; ++g) {
            const int ai = g >> 2, m = g & 3;
            const int r = row0 + ai * HALF + m * 16; float ss = 0.f;
            if (g < 7) { const int rn = row0 + ((g + 1) >> 2) * HALF + ((g + 1) & 3) * 16;
#pragma unroll
                for (int bj = 0; bj < 2; ++bj)
#pragma unroll
                    for (int n = 0; n < 2; ++n) hnx[bj][n] = *(const h16x4*)(HB + (size_t)rn * D + col0 + bj * HALF + n * 16); }
#pragma unroll
            for (int bj = 0; bj < 2; ++bj)
#pragma unroll
                for (int n = 0; n < 2; ++n) {
                    const size_t o = (size_t)r * D + col0 + bj * HALF + n * 16;
                    f32x4 hv; hv[0] = (float)hin[bj][n][0]; hv[1] = (float)hin[bj][n][1]; hv[2] = (float)hin[bj][n][2]; hv[3] = (float)hin[bj][n][3];
                    hv += acc[ai][bj][m][n];
                    ss += hv[0] * hv[0] + hv[1] * hv[1] + hv[2] * hv[2] + hv[3] * hv[3];
                    if (OUT != nullptr) *(f32x4*)(OUT + o) = hv;
                    else { h16x4 hh; hh[0] = (h16)hv[0]; hh[1] = (h16)hv[1]; hh[2] = (h16)hv[2]; hh[3] = (h16)hv[3]; *(h16x4*)(HB + o) = hh; }
                }
            ss += __shfl_xor(ss, 16); ss += __shfl_xor(ss, 32);
            if (fq == 0) atomicAdd(rsq_next + r, ss);
#pragma unroll
            for (int bj = 0; bj < 2; ++bj)
#pragma unroll
                for (int n = 0; n < 2; ++n) hin[bj][n] = hnx[bj][n];
        }
    }
};

template <int CTRL> __device__ __forceinline__ float dppmov(const float oldv, const float src) {
    return __builtin_bit_cast(float, __builtin_amdgcn_update_dpp(__builtin_bit_cast(int, oldv), __builtin_bit_cast(int, src), CTRL, 0xf, 0xf, false)); }
struct EpiUpFused {
    static constexpr bool PERM = true;
    h16* act; const float* rowsq; const float* cw; const float* cb; h16* sb; LAS float* xch;
    __device__ __forceinline__ void operator()(const f32x4 (&acc_c)[2][2][4][2], const Unit& u, int wr, int wc, int fr, int fq) const {
        f32x4 (&acc)[2][2][4][2] = const_cast<f32x4 (&)[2][2][4][2]>(acc_c);
        const int row0 = u.pm * BM + wr * 64 + fr, jl = wc * 32 + 8 * fq, ch0 = u.pn * 128 + jl;
        float rsv[2][4];
#pragma unroll
        for (int ai = 0; ai < 2; ++ai)
#pragma unroll
            for (int m = 0; m < 4; ++m) rsv[ai][m] = rowsq[row0 + ai * HALF + m * 16];
#pragma unroll
        for (int ai = 0; ai < 2; ++ai)
#pragma unroll
            for (int m = 0; m < 4; ++m) { const float rs = rsqrtf(rsv[ai][m] * (1.0f / 1024.0f) + EPS);
#pragma unroll
                for (int bj = 0; bj < 2; ++bj)
#pragma unroll
                    for (int n = 0; n < 2; ++n) acc[ai][bj][m][n] *= rs; }
        if (fr >= 14) {
#pragma unroll
            for (int ai = 0; ai < 2; ++ai)
#pragma unroll
                for (int bj = 0; bj < 2; ++bj)
#pragma unroll
                    for (int n = 0; n < 2; ++n) *(LAS f32x4*)(xch + ((ai * 2 + wr) * 4 + wc) * 128 + (fr - 14) * 64 + bj * 32 + 8 * fq + 4 * n) = acc[ai][bj][3][n];
        }
        if ((wr == 1 && fr >= 14) || (wr == 0 && fr < 2)) {
            const int ai = wr, m = wr ? 3 : 0, srow = wr ? (2 + fr - 14) : fr;
#pragma unroll
            for (int bj = 0; bj < 2; ++bj) { const f32x4 a = wr ? acc[1][bj][3][0] : acc[0][bj][0][0], b = wr ? acc[1][bj][3][1] : acc[0][bj][0][1];
                *(u32x4*)(sb + ((size_t)u.pm * 4 + srow) * FF2 + u.pn * 256 + bj * 128 + jl) = pack8(a, b); }
            (void)ai; (void)m;
        }
        asm volatile("s_waitcnt lgkmcnt(0)" ::: "memory");
        __builtin_amdgcn_s_barrier(); __builtin_amdgcn_s_barrier();
        asm volatile("" ::: "memory");
#pragma unroll
        for (int n = 0; n < 2; ++n) {
            f32x4 wg[3], wv[3], bg, bv;
#pragma unroll
            for (int t = 0; t < 3; ++t) { wg[t] = *(const f32x4*)(cw + t * FF2 + ch0 + 4 * n); wv[t] = *(const f32x4*)(cw + t * FF2 + FF + ch0 + 4 * n); }
            bg = *(const f32x4*)(cb + ch0 + 4 * n); bv = *(const f32x4*)(cb + FF + ch0 + 4 * n);
#pragma unroll
            for (int ai = 0; ai < 2; ++ai) {
                f32x4 xpg = {0.f, 0.f, 0.f, 0.f}, xpv = {0.f, 0.f, 0.f, 0.f};
                const bool top = (ai == 0 && wr == 0);
                if (!top && fr >= 14) { const int ps = (wr == 1) ? ((ai * 2) * 4 + wc) : (((ai - 1) * 2 + 1) * 4 + wc);
                    xpg = *(const LAS f32x4*)(xch + ps * 128 + (fr - 14) * 64 + 8 * fq + 4 * n); xpv = *(const LAS f32x4*)(xch + ps * 128 + (fr - 14) * 64 + 32 + 8 * fq + 4 * n); }
#pragma unroll
                for (int m = 0; m < 4; ++m) {
                    const f32x4 cg = acc[ai][0][m][n], cv = acc[ai][1][m][n];
                    const f32x4 pg = m ? acc[ai][0][m - 1][n] : xpg, pv = m ? acc[ai][1][m - 1][n] : xpv;
                    h16x4 o;
#pragma unroll
                    for (int e = 0; e < 4; ++e) {
                        const float g1 = dppmov<0x111>(dppmov<0x121>(0.f, pg[e]), cg[e]), g2 = dppmov<0x112>(dppmov<0x122>(0.f, pg[e]), cg[e]);
                        const float v1 = dppmov<0x111>(dppmov<0x121>(0.f, pv[e]), cv[e]), v2 = dppmov<0x112>(dppmov<0x122>(0.f, pv[e]), cv[e]);
                        const float gate = wg[0][e] * g2 + wg[1][e] * g1 + wg[2][e] * cg[e] + bg[e];
                        const float val = wv[0][e] * v2 + wv[1][e] * v1 + wv[2][e] * cv[e] + bv[e];
                        o[e] = (h16)(silu_f(gate) * val);
                    }
                    *(h16x4*)(act + (size_t)(row0 + ai * HALF + m * 16) * FF + ch0 + 4 * n) = o;
                }
            }
        }
    }
};

struct EpiOddIn {
    static constexpr bool PERM = true;
    h16* O; int ldc; const float* rowsq; const float* gtab; LAS float* xch;
    __device__ __forceinline__ void operator()(const f32x4 (&acc_c)[2][2][4][2], const Unit& u, int wr, int wc, int fr, int fq) const {
        f32x4 (&acc)[2][2][4][2] = const_cast<f32x4 (&)[2][2][4][2]>(acc_c);
        const int row0 = u.pm * BM + wr * 64 + fr, col0 = u.pn * BM + wc * 32 + 8 * fq;
        const int pn = u.pn;
        const int kind0 = pn < 4 ? 1 : ((pn == 6 || pn == 7 || pn == 8) ? 2 : 0), kind1 = pn < 4 ? 1 : ((pn == 6 || pn == 7) ? 2 : 0);
        float rsv[2][4];
#pragma unroll
        for (int ai = 0; ai < 2; ++ai)
#pragma unroll
            for (int m = 0; m < 4; ++m) rsv[ai][m] = rowsq[row0 + ai * HALF + m * 16];
#pragma unroll
        for (int ai = 0; ai < 2; ++ai)
#pragma unroll
            for (int m = 0; m < 4; ++m) { const float rs = rsqrtf(rsv[ai][m] * (1.0f / 1024.0f) + EPS);
#pragma unroll
                for (int bj = 0; bj < 2; ++bj)
#pragma unroll
                    for (int n = 0; n < 2; ++n) acc[ai][bj][m][n] *= rs; }
        if (kind0 != 0) {
            const int kidx = pn < 2 ? 0 : (pn < 4 ? 1 : (pn < 8 ? 2 : 3));
            const int gcol = (kind0 == 1 ? 32 * (wc & 1) : 32 * wc) + 8 * fq;
            const f32x4 ga = *(const f32x4*)(gtab + kidx * 128 + gcol), gb = *(const f32x4*)(gtab + kidx * 128 + gcol + 4);
            const float gscale = 1.0f;
#pragma unroll
            for (int ai = 0; ai < 2; ++ai)
#pragma unroll
                for (int m = 0; m < 4; ++m)
#pragma unroll
                    for (int bj = 0; bj < 2; ++bj) { const f32x4 a = acc[ai][bj][m][0], b = acc[ai][bj][m][1];
                        float ss = (a[0] * a[0] + a[1] * a[1]) + (a[2] * a[2] + a[3] * a[3]) + (b[0] * b[0] + b[1] * b[1]) + (b[2] * b[2] + b[3] * b[3]);
                        ss += __shfl_xor(ss, 16); ss += __shfl_xor(ss, 32);
                        if (fq == 0) xch[((ai * HALF + wr * 64 + m * 16 + fr) * 2 + bj) * 4 + wc] = ss; }
            asm volatile("s_waitcnt lgkmcnt(0)" ::: "memory");
            __builtin_amdgcn_s_barrier(); __builtin_amdgcn_s_barrier();
            asm volatile("" ::: "memory");
#pragma unroll
            for (int ai = 0; ai < 2; ++ai)
#pragma unroll
                for (int m = 0; m < 4; ++m)
#pragma unroll
                    for (int bj = 0; bj < 2; ++bj) { const int kind = bj ? kind1 : kind0;
                        if (kind != 0) {
                            const f32x4 pp = *(const LAS f32x4*)(xch + ((ai * HALF + wr * 64 + m * 16 + fr) * 2 + bj) * 4);
                            const float sum = kind == 1 ? ((wc & 2) ? (pp[2] + pp[3]) : (pp[0] + pp[1])) : ((pp[0] + pp[1]) + (pp[2] + pp[3]));
                            const float gr = rsqrtf(sum * (kind == 1 ? (1.f / 64.f) : (1.f / 128.f)) + EPS) * gscale;
                            acc[ai][bj][m][0] *= ga * gr; acc[ai][bj][m][1] *= gb * gr; } }
        }
#pragma unroll
        for (int ai = 0; ai < 2; ++ai)
#pragma unroll
            for (int m = 0; m < 4; ++m) { const int r = row0 + ai * HALF + m * 16;
#pragma unroll
                for (int bj = 0; bj < 2; ++bj) *(u32x4*)(O + (size_t)r * ldc + col0 + bj * HALF) = pack8(acc[ai][bj][m][0], acc[ai][bj][m][1]); }
    }
};
}

__device__ __forceinline__ void map_col(int mode, int nd, int Nsrc, int& src, float& sc) {
    sc = 1.f;
    if (mode == 0) { src = nd < Nsrc ? nd : -1; }
    else if (mode == 1) { src = nd < 2560 ? nd : (nd < 3072 ? nd + 8 : (nd < 3080 ? nd - 512 : -1)); }
    else if (mode == 3) { const int pt = nd >> 8, rr = nd & 255; src = rr < 128 ? 128 * pt + rr : FF + 128 * pt + (rr - 128); }
    else { src = nd < Nsrc ? nd : -1; if (nd >= 2304 && nd < 2816) sc = 0.125f; if (nd >= 2880 && nd < 2888) sc = 0.35355339059f; }
}
__device__ __forceinline__ void conv_weight(const int wid_s, LAS float* tile, const float* __restrict__ W, int K, int Nsrc, h16* __restrict__ Wt, int Npad, const float* __restrict__ g, int mode) {
    int tid_ = TIDX; asm volatile("" : "+v"(tid_));
    const int tid = tid_, ktiles = K / 64, ntiles = Npad / 64;
    for (int t = blockIdx.x; t < ktiles * ntiles; t += gridDim.x) {
        const int nt = t / ktiles, kt = t % ktiles;
        {   const int n = tid & 63, nd = nt * 64 + n; int src; float sc; map_col(mode, nd, Nsrc, src, sc);
            const bool ok = src >= 0; const int sidx = ok ? src : 0; if (!ok) sc = 0.f;
            float vals[8], gv[8];
#pragma unroll
            for (int i = 0; i < 8; ++i) { const int k = i * 8 + (tid >> 6); vals[i] = W[(size_t)(kt * 64 + k) * Nsrc + sidx]; gv[i] = g ? g[kt * 64 + k] : 1.f; }
#pragma unroll
            for (int i = 0; i < 8; ++i) { const int k = i * 8 + (tid >> 6); tile[k * 65 + n] = vals[i] * sc * gv[i]; }
        }
        __syncthreads();
#pragma unroll
        for (int i = 0; i < 8; ++i) { const int n = i * 8 + (tid >> 6), k = tid & 63; Wt[(size_t)(nt * 64 + n) * K + kt * 64 + k] = (h16)tile[k * 65 + n]; }
        __syncthreads();
    }
}

__device__ __forceinline__ void phase_prep(const int wid_s, CParams& p, LAS unsigned char* lds) {
    int tid_ = TIDX; asm volatile("" : "+v"(tid_));
    const int tid = tid_, lane = tid & 63, wave = tid >> 6;
    unsigned char* ws = p.ws;
    LAS float* tile = (LAS float*)lds;
    const float* mix_g = p.in[2]; const float* ffn_g = p.in[19];
    for (int l = 0; l < DEPTH; ++l) {
        const int j = l >> 1;
        if ((l & 1) == 0) conv_weight(wid_s, tile, p.in[3] + (size_t)j * D * EV_SRC, D, EV_SRC, (h16*)(ws + WS_WIN_E + j * SZ_WIN_E), EV_N, mix_g + l * D, 1);
        else conv_weight(wid_s, tile, p.in[11] + (size_t)j * D * OD_SRC, D, OD_SRC, (h16*)(ws + WS_WIN_O + j * SZ_WIN_O), OD_N, mix_g + l * D, 2);
        const float* wo = (l & 1) == 0 ? p.in[4] + (size_t)j * D * D : p.in[12] + (size_t)j * D * D;
        conv_weight(wid_s, tile, wo, D, D, (h16*)(ws + WS_WOUT + l * SZ_WOUT), D, nullptr, 0);
        conv_weight(wid_s, tile, p.in[20] + (size_t)l * D * FF2, D, FF2, (h16*)(ws + WS_WUP + l * SZ_WUP), FF2, ffn_g + l * D, 3);
        conv_weight(wid_s, tile, p.in[23] + (size_t)l * FF * D, FF, D, (h16*)(ws + WS_WDN + l * SZ_WDN), D, nullptr, 0);
    }
    const float* x = p.in[0]; float* out = p.out; h16* hb = (h16*)(ws + WS_HB); float* rsq = (float*)(ws + WS_RSQ);
    const int bid8 = opaque_bid() * 8;
    for (int row = bid8 + wave; row < T; row += gridDim.x * 8) {
        float ss = 0.f;
        f32x4 xv4[4];
#pragma unroll
        for (int i = 0; i < 4; ++i) xv4[i] = *(const f32x4*)(x + (size_t)row * D + i * 256 + lane * 4);
#pragma unroll
        for (int i = 0; i < 4; ++i) {
            const size_t o = (size_t)row * D + i * 256 + lane * 4;
            const f32x4 v = xv4[i];
            h16x4 hh; hh[0] = (h16)v[0]; hh[1] = (h16)v[1]; hh[2] = (h16)v[2]; hh[3] = (h16)v[3]; *(h16x4*)(hb + o) = hh;
            ss += v[0] * v[0] + v[1] * v[1] + v[2] * v[2] + v[3] * v[3];
        }
        ss = wave_sum(ss);
        if (lane == 0) rsq[row] = ss;
    }
    for (size_t i = (size_t)opaque_bid() * NTHREADS + tid; i < (size_t)8 * T; i += (size_t)gridDim.x * NTHREADS) rsq[T + i] = 0.f;
    { const float* ws_ = p.in[5]; h16* gws = (h16*)(ws + WS_GWS);
      for (int i = opaque_bid() * NTHREADS + tid; i < 2 * 4 * 128 * 128; i += gridDim.x * NTHREADS) { const int s = i & 127, t = (i >> 7) & 127; gws[i] = (h16)(s <= t ? ws_[i] : 0.f); } }
    if (blockIdx.x == 0) {
        const float* rb = p.in[1]; float* bd = (float*)(ws + WS_BIASD);
        for (int i = tid; i < 8 * 129; i += NTHREADS) {
            const int h = i / 129, d = i % 129; int bucket;
            if (d < 16) bucket = d; else { const float nf = (float)d; int far = 16 + (int)(logf(nf / 16.0f) / 2.0794415416798357f * 16.0f); bucket = far < 31 ? far : 31; }
            bd[h * 132 + d] = rb[bucket * 8 + h] * 1.4426950408889634f;
        }
        { float* gt = (float*)(ws + WS_GTAB);
          for (int i = tid; i < 2 * 4 * 128; i += NTHREADS) { const int jj = i >> 9, kd = (i >> 7) & 3, c = i & 127;
              float v;
              if (kd == 0) v = p.in[13][jj * 64 + (c & 63)] * (0.125f * 1.4426950408889634f);
              else if (kd == 1) v = p.in[14][jj * 64 + (c & 63)];
              else if (kd == 2) v = p.in[17][jj * 128 + c] * (0.08838834764831845f * 1.4426950408889634f);
              else v = p.in[18][jj * 128 + c];
              gt[i] = v; } }
        if (tid < 2) { const float* dl = p.in[15] + tid * 4 * 64; float s1 = 0.f, s2 = 0.f; for (int i = 0; i < 64; ++i) { s1 += dl[i] * dl[64 + i]; s2 += dl[128 + i] * dl[192 + i]; }
            const int layer = 2 * tid + 1; const float li = 0.8f - 0.6f * expf(-0.3f * (float)layer);
            float* misc = (float*)(ws + WS_MISC); misc[tid * 2] = expf(s1) - expf(s2) + li; misc[tid * 2 + 1] = li; }
    }
}

__device__ __forceinline__ void phase_ffn_conv(const int wid_s, h16* up, const h16* halo, const float* __restrict__ cw, const float* __restrict__ cb) {
    const int nth = gridDim.x * NTHREADS;
    int tid_ = TIDX; asm volatile("" : "+v"(tid_));
    for (int idx = opaque_bid() * NTHREADS + tid_; idx < (T / 64) * (FF / 8); idx += nth) {
        const int cgp = idx % (FF / 8), rb = idx / (FF / 8), ch = cgp * 8, t0 = rb * 64;
        float wg[3][8], wv[3][8], bg[8], bv[8];
#pragma unroll
        for (int j = 0; j < 3; ++j)
#pragma unroll
            for (int c = 0; c < 8; ++c) { wg[j][c] = cw[j * FF2 + ch + c]; wv[j][c] = cw[j * FF2 + FF + ch + c]; }
#pragma unroll
        for (int c = 0; c < 8; ++c) { bg[c] = cb[ch + c]; bv[c] = cb[FF + ch + c]; }
        float g2[8], g1[8], v2[8], v1[8];
        if ((rb & 63) == 0) {
#pragma unroll
            for (int c = 0; c < 8; ++c) { g2[c] = g1[c] = v2[c] = v1[c] = 0.f; }
        } else {
            const h16* hp = halo + (size_t)(rb - 1) * 2 * FF2;
            const h16x8 a = *(const h16x8*)(hp + ch), b = *(const h16x8*)(hp + FF + ch), c2 = *(const h16x8*)(hp + FF2 + ch), d2 = *(const h16x8*)(hp + FF2 + FF + ch);
#pragma unroll
            for (int c = 0; c < 8; ++c) { g2[c] = (float)a[c]; v2[c] = (float)b[c]; g1[c] = (float)c2[c]; v1[c] = (float)d2[c]; }
        }
        h16* rp = up + (size_t)t0 * FF2 + ch;
#pragma unroll 1
        for (int r4 = 0; r4 < 16; ++r4) {
            h16x8 gcv[4], vcv[4];
#pragma unroll
            for (int q = 0; q < 4; ++q) { gcv[q] = *(const h16x8*)(rp + (size_t)q * FF2); vcv[q] = *(const h16x8*)(rp + (size_t)q * FF2 + FF); }
#pragma unroll
            for (int q = 0; q < 4; ++q) {
                h16x8 o;
#pragma unroll
                for (int c = 0; c < 8; ++c) {
                    const float g0 = (float)gcv[q][c], v0 = (float)vcv[q][c];
                    const float gate = wg[0][c] * g2[c] + wg[1][c] * g1[c] + wg[2][c] * g0 + bg[c];
                    const float val = wv[0][c] * v2[c] + wv[1][c] * v1[c] + wv[2][c] * v0 + bv[c];
                    o[c] = (h16)(silu_f(gate) * val);
                    g2[c] = g1[c]; g1[c] = g0; v2[c] = v1[c]; v1[c] = v0;
                }
                *(h16x8*)(rp + (size_t)q * FF2) = o;
            }
            rp += 4 * FF2;
        }
    }
}


__device__ __forceinline__ void phase_ffn_fixup(const int wid_s, h16* act, const h16* sb, const float* __restrict__ cw, const float* __restrict__ cb) {
    int tid_ = TIDX; asm volatile("" : "+v"(tid_));
    const int nth = gridDim.x * NTHREADS;
    for (int idx = opaque_bid() * NTHREADS + tid_; idx < (T / 256) * (FF / 8); idx += nth) {
        const int cgp = idx % (FF / 8), pm = idx / (FF / 8), ch = cgp * 8;
        if ((pm & 15) == 0) continue;
        const int col = 256 * (ch >> 7) + (ch & 127);
        const h16* s0 = sb + (size_t)pm * 4 * FF2 + col; const h16* sp = sb + (size_t)(pm - 1) * 4 * FF2 + col;
        const h16x8 g254 = *(const h16x8*)(sp + 2 * FF2), v254 = *(const h16x8*)(sp + 2 * FF2 + 128), g255 = *(const h16x8*)(sp + 3 * FF2), v255 = *(const h16x8*)(sp + 3 * FF2 + 128);
        const h16x8 g0 = *(const h16x8*)(s0), v0 = *(const h16x8*)(s0 + 128), g1 = *(const h16x8*)(s0 + FF2), v1 = *(const h16x8*)(s0 + FF2 + 128);
        h16x8 o0, o1;
#pragma unroll
        for (int c = 0; c < 8; ++c) {
            const float wg0 = cw[ch + c], wg1 = cw[FF2 + ch + c], wg2 = cw[2 * FF2 + ch + c], wv0 = cw[FF + ch + c], wv1 = cw[FF2 + FF + ch + c], wv2 = cw[2 * FF2 + FF + ch + c];
            const float bgc = cb[ch + c], bvc = cb[FF + ch + c];
            const float ga = wg0 * (float)g254[c] + wg1 * (float)g255[c] + wg2 * (float)g0[c] + bgc, va = wv0 * (float)v254[c] + wv1 * (float)v255[c] + wv2 * (float)v0[c] + bvc;
            const float gb = wg0 * (float)g255[c] + wg1 * (float)g0[c] + wg2 * (float)g1[c] + bgc, vb = wv0 * (float)v255[c] + wv1 * (float)v0[c] + wv2 * (float)v1[c] + bvc;
            o0[c] = (h16)(silu_f(ga) * va); o1[c] = (h16)(silu_f(gb) * vb);
        }
        *(h16x8*)(act + (size_t)(pm * 256) * FF + ch) = o0; *(h16x8*)(act + (size_t)(pm * 256 + 1) * FF + ch) = o1;
    }
}

__device__ __forceinline__ f32x4 mma16(const h16x8 a, const h16x8 b, const f32x4 c) { return __builtin_amdgcn_mfma_f32_16x16x32_f16(a, b, c, 0, 0, 0); }
constexpr int EM_QN = 0, EM_KN = 17408, EM_KB = 34816, EM_KBGT = 52224, EM_VBT = 70656, EM_LM = 89088, EM_M0 = 89088, EM_MT0 = 98304, EM_M1 = 107520, EM_MT1 = 116736, EM_TA0 = 125952, EM_TA1 = 135168, EM_SM = 144384;

__device__ __forceinline__ void phase_even_mix(const int wid_s, CParams& p, int j, LAS unsigned char* lds) {
    int tid_ = TIDX; asm volatile("" : "+v"(tid_));
    const int tid = tid_, lane = tid & 63, wave = tid >> 6, lr = lane & 15, lq = lane >> 4;
    unsigned char* ws = p.ws; unsigned char* R = ws + WS_R;
    h16* proj = (h16*)(R + R_PROJ); h16* y = (h16*)(R + R_Y);
    h16* qg = (h16*)(R + R_QG); h16* kdt = (h16*)(R + R_KDT); h16* intra = (h16*)(R + R_INTRA);
    const float* ba = (const float*)(ws + WS_BA); float* gcl = (float*)(ws + WS_GCL);
    const h16* gws = (const h16*)(ws + WS_GWS) + (size_t)j * 4 * 128 * 128;
    const float* bs = p.in[6] + j * 4 * 128;
    const float* cw = p.in[7] + (size_t)j * 4 * 1536;
    const float* alog = p.in[8] + j * 4; const float* dtb = p.in[9] + j * 4;
    LAS h16* Vt = (LAS h16*)(lds);
    LAS h16* Qn = (LAS h16*)(lds + EM_QN); LAS h16* Kn = (LAS h16*)(lds + EM_KN); LAS h16* KB = (LAS h16*)(lds + EM_KB);
    LAS h16* KBGt = (LAS h16*)(lds + EM_KBGT); LAS h16* VBt = (LAS h16*)(lds + EM_VBT);
    LAS h16* const Mb[2] = {(LAS h16*)(lds + EM_M0), (LAS h16*)(lds + EM_M1)}; LAS h16* const MTb[2] = {(LAS h16*)(lds + EM_MT0), (LAS h16*)(lds + EM_MT1)};
    LAS h16* const TAb[2] = {(LAS h16*)(lds + EM_TA0), (LAS h16*)(lds + EM_TA1)}; LAS h16* T16 = TAb[1];
    LAS float* ssq = (LAS float*)(lds + EM_SM); LAS float* betas = ssq + 128; LAS float* gcs = ssq + 192;
    for (int item = blockIdx.x; item < 2048; item += gridDim.x) {
        int tidi_ = tid_; asm volatile("" : "+v"(tidi_));
        const int tid = tidi_, lane = tid & 63, wave = tid >> 6, lr = lane & 15, lq = lane >> 4;
        const int g = item & 3, n = (item >> 2) & 31, b = item >> 7;
        const int t0 = b * SEQ + n * 128;
        {
            const int s = tid >> 2, q = tid & 3;
            float xv[32]; float sum = 0.f;
#pragma unroll
            for (int i = 0; i < 4; ++i) { const h16x8 v = *(const h16x8*)(proj + (size_t)(t0 + s) * EV_N + 512 + g * 128 + q * 32 + i * 8);
#pragma unroll
                for (int e = 0; e < 8; ++e) { xv[i * 8 + e] = (float)v[e]; sum += xv[i * 8 + e]; } }
            sum += __shfl_xor(sum, 1); sum += __shfl_xor(sum, 2);
            const float mean = sum * (1.f / 128.f); float var = 0.f;
#pragma unroll
            for (int i = 0; i < 32; ++i) { xv[i] -= mean; var += xv[i] * xv[i]; }
            var += __shfl_xor(var, 1); var += __shfl_xor(var, 2);
            const float rstd = rsqrtf(var * (1.f / 128.f) + EPS);
#pragma unroll
            for (int i = 0; i < 32; ++i) Vt[(q * 32 + i) * 136 + s] = (h16)(xv[i] * rstd);
        }
        __syncthreads();
        {
            const h16* gw = gws + (size_t)g * 128 * 128;
            h16x8 af[4];
#pragma unroll
            for (int ks = 0; ks < 4; ++ks) af[ks] = *(const h16x8*)(gw + (16 * wave + lr) * 128 + 32 * ks + 8 * lq);
            h16 uu[8][4]; float bsv[4];
#pragma unroll
            for (int r = 0; r < 4; ++r) bsv[r] = bs[g * 128 + 16 * wave + 4 * lq + r];
#pragma unroll
            for (int nt = 0; nt < 8; ++nt)
#pragma unroll
                for (int r = 0; r < 4; ++r) uu[nt][r] = proj[(size_t)(t0 + 16 * wave + 4 * lq + r) * EV_N + g * 128 + 16 * nt + lr];
#pragma unroll
            for (int nt = 0; nt < 8; ++nt) {
                f32x4 acc = {0.f, 0.f, 0.f, 0.f};
#pragma unroll
                for (int ks = 0; ks < 4; ++ks) if (32 * ks <= 16 * wave + 15) acc = mma16(af[ks], *(const LAS h16x8*)(Vt + (16 * nt + lr) * 136 + 32 * ks + 8 * lq), acc);
#pragma unroll
                for (int r = 0; r < 4; ++r) {
                    const int t = 16 * wave + 4 * lq + r, c = 16 * nt + lr;
                    const float mixed = acc[r] + bsv[r];
                    y[(size_t)(t0 + t) * D + g * 128 + c] = (h16)((float)uu[nt][r] * mixed);
                }
            }
        }
        __syncthreads();
        const int h = g;
#pragma unroll 1
        for (int cc = 0; cc < 2; ++cc) {
            int tidc_ = tidi_; asm volatile("" : "+v"(tidc_));
            const int tid = tidc_, lane = tid & 63, wave = tid >> 6, lr = lane & 15, lq = lane >> 4;
            const int tc0 = t0 + cc * 64; const int tin = (n * 128 + cc * 64);
            const int chh = (tc0 >> 6) * 4 + h;
            if (tid < 128) ssq[tid] = 0.f;
            __syncthreads();
            LAS h16* KDs = (LAS h16*)(lds + EM_LM);
#pragma unroll 1
            for (int pass = 0; pass < 2; ++pass) {
                if (tid < 384) {
                    const int gq = tid % 48, part = gq >> 4, c8 = (gq & 15) * 8, tok8 = (tid / 48) * 8;
                    float wv[4][8];
#pragma unroll
                    for (int jj = 0; jj < 4; ++jj)
#pragma unroll
                        for (int e = 0; e < 8; ++e) wv[jj][e] = cw[jj * 1536 + part * 512 + h * 128 + c8 + e];
                    const h16* xp = proj + (size_t)tc0 * EV_N + 1024 + part * 512 + h * 128 + c8;
                    const float glast = pass ? gcs[63] : 0.f;
                    h16x8 xa[11];
#pragma unroll
                    for (int r = 0; r < 11; ++r) { const int tt = tok8 - 3 + r; const bool okr = tin + tt >= 0;
                        xa[r] = *(const h16x8*)(xp + (long)(okr ? tt : 0) * EV_N);
                        if (!okr) {
#pragma unroll
                            for (int e = 0; e < 8; ++e) xa[r][e] = (h16)0.f; } }
#pragma unroll 1
                    for (int hf = 0; hf < 2; ++hf) {
                    h16x8 xr[7];
#pragma unroll
                    for (int r = 0; r < 7; ++r) xr[r] = hf ? xa[r + 4] : xa[r];
#pragma unroll
                    for (int i = 0; i < 4; ++i) {
                        const int t = tok8 + 4 * hf + i; float sq = 0.f; float cv[8];
#pragma unroll
                        for (int e = 0; e < 8; ++e) { const float a = wv[0][e] * (float)xr[i][e] + wv[1][e] * (float)xr[i + 1][e] + wv[2][e] * (float)xr[i + 2][e] + wv[3][e] * (float)xr[i + 3][e]; const float sv = silu_f(a); cv[e] = sv; sq += sv * sv; }
                        if (pass == 0) { if (part < 2) atomicAdd((float*)(ssq + part * 64 + t), sq); }
                        else if (part == 0) {
                            const float rn = rsqrtf(ssq[t] + EPS) * 0.08838834764831845f; const float eg = __expf(gcs[t]);
                            h16x8 a, bq;
#pragma unroll
                            for (int e = 0; e < 8; ++e) { const float v = cv[e] * rn; a[e] = (h16)v; bq[e] = (h16)(v * eg); }
                            *(LAS h16x8*)(Qn + t * 136 + c8) = a; *(h16x8*)(qg + (size_t)(tc0 + t) * 512 + h * 128 + c8) = bq;
                        } else if (part == 1) {
                            const float rn = rsqrtf(ssq[64 + t] + EPS); const float be = betas[t]; const float gt = gcs[t]; const float e1 = be * __expf(gt), e2 = __expf(glast - gt);
                            h16x8 a, bq;
#pragma unroll
                            for (int e = 0; e < 8; ++e) { const float v = cv[e] * rn; a[e] = (h16)v; bq[e] = (h16)(v * be); KBGt[(c8 + e) * 72 + t] = (h16)(v * e1); KDs[(c8 + e) * 72 + t] = (h16)(v * e2); }
                            *(LAS h16x8*)(Kn + t * 136 + c8) = a; *(LAS h16x8*)(KB + t * 136 + c8) = bq;
                        } else {
                            const float be = betas[t];
#pragma unroll
                            for (int e = 0; e < 8; ++e) VBt[(c8 + e) * 72 + t] = (h16)(cv[e] * be);
                        }
                    }
                    }
                } else if (tid < 448 && pass == 0) {
                    const int t = tid - 384;
                    const float braw = ba[(size_t)(tc0 + t) * 8 + h], araw = ba[(size_t)(tc0 + t) * 8 + 4 + h];
                    const float beta = 1.f / (1.f + __expf(-braw));
                    const float xx = araw + dtb[h];
                    const float sp = xx > 20.f ? xx : log1pf(__expf(xx));
                    float gt = -__expf(alog[h]) * sp;
#pragma unroll
                    for (int o = 1; o < 64; o <<= 1) { const float v = __shfl_up(gt, o); if (t >= o) gt += v; }
                    betas[t] = beta; gcs[t] = gt;
                    if (t == 63) gcl[chh] = gt;
                }
                __syncthreads();
            }
            for (int i = tid; i < 128 * 8; i += NTHREADS) { const int k = i >> 3, c8 = (i & 7) * 8; *(h16x8*)(kdt + ((size_t)chh * 128 + k) * 64 + c8) = *(const LAS h16x8*)(KDs + k * 72 + c8); }
            __syncthreads();
            {
                const int sel = wave >> 2, mt = wave & 3;
                const LAS h16* Am = sel ? Qn : KB;
                h16x8 af[4];
#pragma unroll
                for (int ks = 0; ks < 4; ++ks) af[ks] = *(const LAS h16x8*)(Am + (16 * mt + lr) * 136 + 32 * ks + 8 * lq);
#pragma unroll
                for (int nt = 0; nt < 4; ++nt) {
                    f32x4 acc = {0.f, 0.f, 0.f, 0.f};
#pragma unroll
                    for (int ks = 0; ks < 4; ++ks) acc = mma16(af[ks], *(const LAS h16x8*)(Kn + (16 * nt + lr) * 136 + 32 * ks + 8 * lq), acc);
                    const int jc = 16 * nt + lr; const float gj = gcs[jc];
                    h16x4 lt;
#pragma unroll
                    for (int r = 0; r < 4; ++r) { const int i = 16 * mt + 4 * lq + r;
                        const float dec = (jc <= i) ? __expf(gcs[i] - gj) : 0.f;
                        const h16 lv = (h16)((jc < i) ? acc[r] * dec : 0.f); lt[r] = lv;
                        if (sel == 0) Mb[0][i * 72 + jc] = lv;
                        else intra[((size_t)chh * 64 + i) * 64 + jc] = (h16)(acc[r] * dec); }
                    if (sel == 0) *(LAS h16x4*)(MTb[0] + jc * 72 + 16 * mt + 4 * lq) = lt;
                }
            }
            __syncthreads();
            {
                const int mt = wave >> 1, nt0 = 2 * (wave & 1);
                f32x4 tacc[2];
#pragma unroll
                for (int t = 0; t < 2; ++t) { const int jc = 16 * (nt0 + t) + lr;
#pragma unroll
                    for (int r = 0; r < 4; ++r) { const int i = 16 * mt + 4 * lq + r; const float v = ((i == jc) ? 1.f : 0.f) - (float)Mb[0][i * 72 + jc]; tacc[t][r] = v; TAb[0][i * 72 + jc] = (h16)v; } }
#define NEU_SQUARE(src, dst) do { _Pragma("unroll") for (int t = 0; t < 2; ++t) { f32x4 a_ = {0.f, 0.f, 0.f, 0.f}; \
                    _Pragma("unroll") for (int ks = 0; ks < 2; ++ks) a_ = mma16(*(const LAS h16x8*)(Mb[src] + (16 * mt + lr) * 72 + 32 * ks + 8 * lq), *(const LAS h16x8*)(MTb[src] + (16 * (nt0 + t) + lr) * 72 + 32 * ks + 8 * lq), a_); \
                    const int jc_ = 16 * (nt0 + t) + lr; h16x4 lt_; \
                    _Pragma("unroll") for (int r = 0; r < 4; ++r) { lt_[r] = (h16)a_[r]; Mb[dst][(16 * mt + 4 * lq + r) * 72 + jc_] = lt_[r]; } \
                    *(LAS h16x4*)(MTb[dst] + jc_ * 72 + 16 * mt + 4 * lq) = lt_; } } while (0)
                NEU_SQUARE(0, 1);
                __syncthreads();
#pragma unroll
                for (int st = 0; st < 5; ++st) {
                    const int mc = (st + 1) & 1, tc = st & 1;
#pragma unroll
                    for (int t = 0; t < 2; ++t) {
#pragma unroll
                        for (int ks = 0; ks < 2; ++ks) tacc[t] = mma16(*(const LAS h16x8*)(TAb[tc] + (16 * mt + lr) * 72 + 32 * ks + 8 * lq), *(const LAS h16x8*)(MTb[mc] + (16 * (nt0 + t) + lr) * 72 + 32 * ks + 8 * lq), tacc[t]);
                        const int jc = 16 * (nt0 + t) + lr;
#pragma unroll
                        for (int r = 0; r < 4; ++r) TAb[tc ^ 1][(16 * mt + 4 * lq + r) * 72 + jc] = (h16)tacc[t][r];
                    }
                    if (st < 4) NEU_SQUARE(mc, mc ^ 1);
                    __syncthreads();
                }
#undef NEU_SQUARE
            }
            {
                const int sel = wave >> 2, mt = wave & 3;
                const LAS h16* Bm = sel ? KBGt : VBt;
                h16x8 af[2];
#pragma unroll
                for (int ks = 0; ks < 2; ++ks) af[ks] = *(const LAS h16x8*)(T16 + (16 * mt + lr) * 72 + 32 * ks + 8 * lq);
#pragma unroll
                for (int nt = 0; nt < 8; ++nt) {
                    f32x4 acc = {0.f, 0.f, 0.f, 0.f};
#pragma unroll
                    for (int ks = 0; ks < 2; ++ks) acc = mma16(af[ks], *(const LAS h16x8*)(Bm + (16 * nt + lr) * 72 + 32 * ks + 8 * lq), acc);
#pragma unroll
                    for (int r = 0; r < 4; ++r) { const int i = 16 * mt + 4 * lq + r, d = 16 * nt + lr;
                        proj[(size_t)(tc0 + i) * EV_N + (sel ? 0 : 512) + h * 128 + d] = (h16)acc[r]; }
                }
            }
            __syncthreads();
        }
    }
}

__device__ __forceinline__ void phase_gdn_scan(const int wid_s, CParams& p, LAS unsigned char* lds) {
    int tid_ = TIDX; asm volatile("" : "+v"(tid_));
    const int tid = tid_, lane = tid & 63, wave = tid >> 6, lr = lane & 15, lq = lane >> 4;
    unsigned char* ws = p.ws; unsigned char* R = ws + WS_R;
    const h16* proj = (const h16*)(R + R_PROJ); h16* y = (h16*)(R + R_Y);
    const h16* qg = (const h16*)(R + R_QG); const h16* kdt = (const h16*)(R + R_KDT); const h16* intra = (const h16*)(R + R_INTRA);
    const float* gcl = (const float*)(ws + WS_GCL);
    LAS h16* St = (LAS h16*)lds;
    LAS h16* Vnt = (LAS h16*)(lds + 17408);
    for (int chain = blockIdx.x; chain < 256; chain += gridDim.x) {
        const int b = chain >> 4, h = (chain >> 2) & 3, sl = chain & 3;
        for (int i = tid; i < 32 * 136; i += NTHREADS) St[i] = (h16)0.f;
        f32x4 st[2] = {{0.f, 0.f, 0.f, 0.f}, {0.f, 0.f, 0.f, 0.f}};
        const int vt = wave & 1, wq = wave >> 1;
        __syncthreads();
        int cur = 0;
        h16x8 wf[4], qf[4], inf[2], kf[2][2]; h16x4 uu; float egl;
        h16x8 wfn[4], qfn[4], infn[2], kfn[2][2]; h16x4 uun; float egln;
#define SCAN_LOAD(WF, UU, QF, INF, KF, EGL, nn) do { const int tc_ = b * SEQ + (nn) * 64; const int ch_ = (tc_ >> 6) * 4 + h; \
            _Pragma("unroll") for (int ks = 0; ks < 4; ++ks) WF[ks] = *(const h16x8*)(proj + (size_t)(tc_ + 16 * wq + lr) * EV_N + h * 128 + 32 * ks + 8 * lq); \
            UU = *(const h16x4*)(proj + (size_t)(tc_ + 16 * wq + lr) * EV_N + 512 + h * 128 + 32 * sl + 16 * vt + 4 * lq); \
            _Pragma("unroll") for (int ks = 0; ks < 4; ++ks) QF[ks] = *(const h16x8*)(qg + (size_t)(tc_ + 16 * wq + lr) * 512 + h * 128 + 32 * ks + 8 * lq); \
            _Pragma("unroll") for (int ks = 0; ks < 2; ++ks) INF[ks] = *(const h16x8*)(intra + ((size_t)ch_ * 64 + 16 * wq + lr) * 64 + 32 * ks + 8 * lq); \
            _Pragma("unroll") for (int i = 0; i < 2; ++i) _Pragma("unroll") for (int ks = 0; ks < 2; ++ks) KF[i][ks] = *(const h16x8*)(kdt + ((size_t)ch_ * 128 + 16 * (2 * wq + i) + lr) * 64 + 32 * ks + 8 * lq); \
            EGL = gcl[ch_]; } while (0)
        SCAN_LOAD(wf, uu, qf, inf, kf, egl, 0);
        for (int n = 0; n < 64; ++n) {
            const int tc0 = b * SEQ + n * 64;
            const LAS h16* Sc = St + cur * (32 * 136); LAS h16* Sn = St + (cur ^ 1) * (32 * 136);
            { const int nn = n + 1 < 64 ? n + 1 : n; SCAN_LOAD(wfn, uun, qfn, infn, kfn, egln, nn); }
            {
                f32x4 acc = {0.f, 0.f, 0.f, 0.f};
#pragma unroll
                for (int ks = 0; ks < 4; ++ks) acc = mma16(*(const LAS h16x8*)(Sc + (16 * vt + lr) * 136 + 32 * ks + 8 * lq), wf[ks], acc);
#pragma unroll
                for (int r = 0; r < 4; ++r) Vnt[(16 * vt + 4 * lq + r) * 72 + 16 * wq + lr] = (h16)((float)uu[r] - acc[r]);
            }
            __syncthreads();
            {
                f32x4 acc = {0.f, 0.f, 0.f, 0.f};
#pragma unroll
                for (int ks = 0; ks < 4; ++ks) acc = mma16(qf[ks], *(const LAS h16x8*)(Sc + (16 * vt + lr) * 136 + 32 * ks + 8 * lq), acc);
#pragma unroll
                for (int ks = 0; ks < 2; ++ks) acc = mma16(inf[ks], *(const LAS h16x8*)(Vnt + (16 * vt + lr) * 72 + 32 * ks + 8 * lq), acc);
#pragma unroll
                for (int r = 0; r < 4; ++r) y[(size_t)(tc0 + 16 * wq + 4 * lq + r) * D + 512 + h * 128 + 32 * sl + 16 * vt + lr] = (h16)acc[r];
            }
#pragma unroll
            for (int i = 0; i < 2; ++i) {
                f32x4 acc = st[i] * __expf(egl);
#pragma unroll
                for (int ks = 0; ks < 2; ++ks) acc = mma16(*(const LAS h16x8*)(Vnt + (16 * vt + lr) * 72 + 32 * ks + 8 * lq), kf[i][ks], acc);
                st[i] = acc;
#pragma unroll
                for (int r = 0; r < 4; ++r) Sn[(16 * vt + 4 * lq + r) * 136 + 16 * (2 * wq + i) + lr] = (h16)acc[r];
            }
            __syncthreads();
            cur ^= 1;
#pragma unroll
            for (int ks = 0; ks < 4; ++ks) { wf[ks] = wfn[ks]; qf[ks] = qfn[ks]; }
#pragma unroll
            for (int ks = 0; ks < 2; ++ks) { inf[ks] = infn[ks]; kf[0][ks] = kfn[0][ks]; kf[1][ks] = kfn[1][ks]; }
            uu = uun; egl = egln;
        }
#undef SCAN_LOAD
    }
}

__device__ __forceinline__ void phase_gdn_gate(const int wid_s, CParams& p, int j) {
    int tid_ = TIDX; asm volatile("" : "+v"(tid_));
    const int tid = tid_, lane = tid & 63, wave = tid >> 6;
    unsigned char* R = p.ws + WS_R; const h16* proj = (const h16*)(R + R_PROJ); h16* y = (h16*)(R + R_Y);
    const float* gn = p.in[10] + j * 128;
    float gg[8];
#pragma unroll
    for (int e = 0; e < 8; ++e) gg[e] = gn[(8 * lane + e) & 127];
    const int bid8 = opaque_bid() * 8;
    for (int t = bid8 + wave; t < T; t += gridDim.x * 8) {
        h16x8* yp = (h16x8*)(y + (size_t)t * D + 512 + 8 * lane);
        h16x8 ov = *yp; const h16x8 zv = *(const h16x8*)(proj + (size_t)t * EV_N + 2560 + 8 * lane);
        float x[8], ss = 0.f;
#pragma unroll
        for (int e = 0; e < 8; ++e) { x[e] = (float)ov[e]; ss += x[e] * x[e]; }
        ss += __shfl_xor(ss, 1); ss += __shfl_xor(ss, 2); ss += __shfl_xor(ss, 4); ss += __shfl_xor(ss, 8);
        const float rs = rsqrtf(ss * (1.f / 128.f) + EPS);
#pragma unroll
        for (int e = 0; e < 8; ++e) ov[e] = (h16)(x[e] * rs * gg[e] * silu_f((float)zv[e]));
        *yp = ov;
    }
}

__device__ __forceinline__ f32x16 mma32(const h16x8 a, const h16x8 b, const f32x16 c) { return __builtin_amdgcn_mfma_f32_32x32x16_f16(a, b, c, 0, 0, 0); }
constexpr size_t R_SC = R_G;

__device__ __forceinline__ void phase_odd_prep(const int wid_s, CParams& p, int j) {
    int tid_ = TIDX; asm volatile("" : "+v"(tid_));
    const int tid = tid_, lane = tid & 63, wave = tid >> 6;
    h16* proj = (h16*)(p.ws + WS_R + R_PROJ);
    const float* gq = p.in[13] + j * 64; const float* gk = p.in[14] + j * 64; const float* gsq = p.in[17] + j * 128; const float* gsk = p.in[18] + j * 128;
    float fq[8], fk[8], fs[8];
#pragma unroll
    for (int e = 0; e < 8; ++e) { fq[e] = gq[(8 * lane + e) & 63] * (0.125f * 1.4426950408889634f); fk[e] = gk[(8 * lane + e) & 63]; fs[e] = gsq[(8 * lane + e) & 127] * (0.08838834764831845f * 1.4426950408889634f); }
    const float fk0 = gsk[2 * lane], fk1 = gsk[2 * lane + 1];
    const int bid8 = opaque_bid() * 8;
    for (int t = bid8 + wave; t < T; t += gridDim.x * 8) {
        h16* row = proj + (size_t)t * OD_N;
        h16x8 va = *(const h16x8*)(row + 8 * lane), vb = *(const h16x8*)(row + 512 + 8 * lane), vc = *(const h16x8*)(row + 1536 + 8 * lane);
        h16x2 vd = *(const h16x2*)(row + 2048 + 2 * lane);
        {   float x[8], ss = 0.f;
#pragma unroll
            for (int e = 0; e < 8; ++e) { x[e] = (float)va[e]; ss += x[e] * x[e]; }
            ss += __shfl_xor(ss, 1); ss += __shfl_xor(ss, 2); ss += __shfl_xor(ss, 4);
            const float rs = rsqrtf(ss * (1.f / 64.f) + EPS);
#pragma unroll
            for (int e = 0; e < 8; ++e) va[e] = (h16)(x[e] * rs * fq[e]);
            *(h16x8*)(row + 8 * lane) = va; }
        {   float x[8], ss = 0.f;
#pragma unroll
            for (int e = 0; e < 8; ++e) { x[e] = (float)vb[e]; ss += x[e] * x[e]; }
            ss += __shfl_xor(ss, 1); ss += __shfl_xor(ss, 2); ss += __shfl_xor(ss, 4);
            const float rs = rsqrtf(ss * (1.f / 64.f) + EPS);
#pragma unroll
            for (int e = 0; e < 8; ++e) vb[e] = (h16)(x[e] * rs * fk[e]);
            *(h16x8*)(row + 512 + 8 * lane) = vb; }
        {   float x[8], ss = 0.f;
#pragma unroll
            for (int e = 0; e < 8; ++e) { x[e] = (float)vc[e]; ss += x[e] * x[e]; }
            ss += __shfl_xor(ss, 1); ss += __shfl_xor(ss, 2); ss += __shfl_xor(ss, 4); ss += __shfl_xor(ss, 8);
            const float rs = rsqrtf(ss * (1.f / 128.f) + EPS);
#pragma unroll
            for (int e = 0; e < 8; ++e) vc[e] = (h16)(x[e] * rs * fs[e]);
            *(h16x8*)(row + 1536 + 8 * lane) = vc; }
        {   const float x0 = (float)vd[0], x1 = (float)vd[1];
            const float ss = wave_sum(x0 * x0 + x1 * x1);
            const float rs = rsqrtf(ss * (1.f / 128.f) + EPS);
            vd[0] = (h16)(x0 * rs * fk0); vd[1] = (h16)(x1 * rs * fk1);
            *(h16x2*)(row + 2048 + 2 * lane) = vd; }
    }
}

__device__ __forceinline__ void diff_attn_item(CParams& p, int j, int layer, LAS unsigned char* lds, int b, int h, int qb, int tid_in, int lane_in, int wave) {
    int tid = tid_in; asm volatile("" : "+v"(tid)); const int lane = tid & 63;
    unsigned char* R = p.ws + WS_R; const h16* proj = (const h16*)(R + R_PROJ); h16* y = (h16*)(R + R_Y);
    const float* bd = (const float*)(p.ws + WS_BIASD) + h * 132; const float* misc = (const float*)(p.ws + WS_MISC);
    LAS h16* Ks0 = (LAS h16*)lds;
    LAS h16* Vt0 = (LAS h16*)(lds + 34816);
    LAS float* bdl = (LAS float*)(lds + 71680);
    LAS float* Ox = (LAS float*)(lds + 73728);
    const int mp = wave >> 2, qs = wave & 3, r = lane & 31, hh = lane >> 5;
    const int tb0 = b * SEQ; const int q0 = qb * 128 + 32 * qs;
    if (tid < 129) bdl[tid] = bd[tid];
    h16x8 qf[4];
#pragma unroll
    for (int s = 0; s < 4; ++s) qf[s] = *(const h16x8*)(proj + (size_t)(tb0 + q0 + r) * OD_N + h * 128 + mp * 64 + 16 * s + 8 * hh);
    f32x16 o[4];
#pragma unroll
    for (int d = 0; d < 4; ++d)
#pragma unroll
        for (int i = 0; i < 16; ++i) o[d][i] = 0.f;
    float m_run = -INFINITY, l_run = 0.f;
    const int qp = q0 + r;
    const int vlo = r * 72 + ((hh ^ (r >> 3)) << 2), vhi = r * 72 + (((hh ^ (r >> 3)) ^ 2) << 2);
    const int nkt = 2 * (qb + 1);
    h16x8 pk[2], pv[2];
#pragma unroll
    for (int i = 0; i < 2; ++i) { const int key = i * 32 + (tid >> 4), ch = tid & 15;
        pk[i] = *(const h16x8*)(proj + (size_t)(tb0 + key) * OD_N + 512 + h * 128 + ch * 8);
        pv[i] = *(const h16x8*)(proj + (size_t)(tb0 + key) * OD_N + 1024 + h * 128 + ch * 8); }
#define ATT_STAGE(buf, KC, VC, ktn) do { LAS h16* Kd_ = Ks0 + (buf) * 8704; LAS h16* Vd_ = Vt0 + (buf) * 9216; \
        _Pragma("unroll") for (int i = 0; i < 2; ++i) { const int key = i * 32 + (tid >> 4), ch = tid & 15; \
            *(LAS h16x8*)(Kd_ + key * 136 + ch * 8) = pk[i]; \
            _Pragma("unroll") for (int e = 0; e < 8; ++e) Vd_[(ch * 8 + e) * 72 + ((((key >> 2) ^ ch) << 2) | (key & 3))] = pv[i][e]; } \
        const int kn_ = ((ktn) < nkt ? (ktn) : nkt - 1) * 64; \
        _Pragma("unroll") for (int i = 0; i < 2; ++i) { const int key = i * 32 + (tid >> 4), ch = tid & 15; \
            pk[i] = *(const h16x8*)(proj + (size_t)(tb0 + kn_ + key) * OD_N + (KC) + ch * 8); \
            pv[i] = *(const h16x8*)(proj + (size_t)(tb0 + kn_ + key) * OD_N + (VC) + ch * 8); } } while (0)
    ATT_STAGE(0, 512 + h * 128, 1024 + h * 128, 1);
    __syncthreads();
    for (int kt = 0; kt < nkt; ++kt) {
        const int k0 = kt * 64; const int cur = kt & 1;
        const LAS h16* Ks = Ks0 + cur * 8704; const LAS h16* Vt = Vt0 + cur * 9216;
        if (kt + 1 < nkt) ATT_STAGE(cur ^ 1, 512 + h * 128, 1024 + h * 128, kt + 2);
        if (!(k0 > q0 + 31)) {
        f32x16 sc[2];
#pragma unroll
        for (int sub = 0; sub < 2; ++sub) {
#pragma unroll
            for (int i = 0; i < 16; ++i) sc[sub][i] = 0.f;
#pragma unroll
            for (int s = 0; s < 4; ++s) sc[sub] = mma32(*(const LAS h16x8*)(Ks + (32 * sub + r) * 136 + mp * 64 + 16 * s + 8 * hh), qf[s], sc[sub]);
        }
        float mx = -INFINITY;
        if (k0 + 63 + 128 <= q0) {
            const float bfar = bdl[128];
#pragma unroll
            for (int sub = 0; sub < 2; ++sub)
#pragma unroll
                for (int i = 0; i < 16; ++i) { sc[sub][i] += bfar; mx = fmaxf(mx, sc[sub][i]); }
        } else {
#pragma unroll
            for (int sub = 0; sub < 2; ++sub)
#pragma unroll
                for (int i = 0; i < 16; ++i) { const int kp = k0 + 32 * sub + (i & 3) + 8 * (i >> 2) + 4 * hh; const int dist = qp - kp;
                    const float v = dist < 0 ? -INFINITY : sc[sub][i] + bdl[dist < 128 ? dist : 128]; sc[sub][i] = v; mx = fmaxf(mx, v); }
        }
        mx = fmaxf(mx, __shfl_xor(mx, 32));
        const float m_new = fmaxf(m_run, mx);
        const float alpha = __builtin_amdgcn_exp2f(m_run - m_new);
        const bool resc = __ballot(m_new > m_run) != 0ull;
        float ls = 0.f;
#pragma unroll
        for (int sub = 0; sub < 2; ++sub)
#pragma unroll
            for (int i = 0; i < 16; ++i) { const float e = __builtin_amdgcn_exp2f(sc[sub][i] - m_new); sc[sub][i] = e; ls += e; }
        ls += __shfl_xor(ls, 32);
        l_run = l_run * alpha + ls; m_run = m_new;
        if (resc) {
#pragma unroll
            for (int d = 0; d < 4; ++d)
#pragma unroll
                for (int i = 0; i < 16; ++i) o[d][i] *= alpha;
        }
#pragma unroll
        for (int sub = 0; sub < 2; ++sub)
#pragma unroll
            for (int s2 = 0; s2 < 2; ++s2) {
                h16x8 pf;
#pragma unroll
                for (int jj = 0; jj < 8; ++jj) pf[jj] = (h16)sc[sub][8 * s2 + jj];
#pragma unroll
                for (int d = 0; d < 4; ++d) {
                    const int coff = 32 * d * 72 + ((((sub << 1) | s2) ^ d) << 4);
                    const h16x4 lo = *(const LAS h16x4*)(Vt + vlo + coff), hi = *(const LAS h16x4*)(Vt + vhi + coff);
                    h16x8 vf; vf[0] = lo[0]; vf[1] = lo[1]; vf[2] = lo[2]; vf[3] = lo[3]; vf[4] = hi[0]; vf[5] = hi[1]; vf[6] = hi[2]; vf[7] = hi[3];
                    o[d] = mma32(vf, pf, o[d]);
                }
            }
        }
        __syncthreads();
    }
    const float inv = 1.f / l_run;
    if (mp == 1) {
#pragma unroll
        for (int d = 0; d < 4; ++d)
#pragma unroll
            for (int i = 0; i < 16; ++i) Ox[(qs * 64 + d * 16 + i) * 64 + lane] = o[d][i] * inv;
    }
    __syncthreads();
    if (mp == 0) {
        const float lam = misc[j * 2], li = misc[j * 2 + 1];
        const float* sg = p.in[16] + j * 128;
        float ss = 0.f;
#pragma unroll
        for (int d = 0; d < 4; ++d)
#pragma unroll
            for (int i = 0; i < 16; ++i) { const float v = o[d][i] * inv - lam * Ox[(qs * 64 + d * 16 + i) * 64 + lane]; o[d][i] = v; ss += v * v; }
        ss += __shfl_xor(ss, 32);
        const float rs = rsqrtf(ss * (1.f / 128.f) + EPS) * (1.f - li);
#pragma unroll
        for (int d = 0; d < 4; ++d)
#pragma unroll
            for (int i = 0; i < 16; ++i) { const int dv = 32 * d + (i & 3) + 8 * (i >> 2) + 4 * hh;
                y[(size_t)(tb0 + q0 + r) * D + h * 128 + dv] = (h16)(o[d][i] * rs * sg[dv]); }
    }
}

constexpr size_t R_BM = (size_t)T * OD_N * 2;
__device__ __forceinline__ void dsa_select_item(CParams& p, LAS unsigned char* lds, int b, int qblk, int tid_in, int wave) {
    int tid = tid_in; asm volatile("" : "+v"(tid)); const int lane = tid & 63;
    unsigned char* R = p.ws + WS_R; const h16* proj = (const h16*)(R + R_PROJ);
    unsigned long long* bm = (unsigned long long*)(R + R_BM);
    float* scw = (float*)(R + R_SC) + (size_t)blockIdx.x * 32 * 4096;
    const int tb0 = b * SEQ; const int q0 = qblk * 32 + 4 * wave;
    {
        LAS h16* Aq = (LAS h16*)(lds + 40960);
        LAS float* Wq = (LAS float*)(lds + 77824);
        __syncthreads();
        {   const int Rr = tid >> 1, half = tid & 1, a = Rr >> 5, r = Rr & 31;
            const int rho = (r & 3) + 4 * (r >> 3), hd = rho & 7, qloc = 2 * ((r >> 2) & 1) + (rho >> 3);
            const h16* src = proj + (size_t)(tb0 + qblk * 32 + 4 * a + qloc) * OD_N + 2304 + hd * 64 + half * 32;
#pragma unroll
            for (int c = 0; c < 4; ++c) *(LAS h16x8*)(Aq + Rr * 72 + half * 32 + c * 8) = *(const h16x8*)(src + c * 8);
            if (tid < 256) Wq[tid] = (float)proj[(size_t)(tb0 + qblk * 32 + (tid >> 3)) * OD_N + 2880 + (tid & 7)];
        }
        __syncthreads();
        const int r = lane & 31, hk = lane >> 5;
        const int nk32 = qblk + 1;
        const h16* kp0 = proj + (size_t)(tb0 + r) * OD_N + 2816 + 8 * hk;
        h16x8 bf[4], bn[4];
        if (wave < nk32) {
#pragma unroll
            for (int s = 0; s < 4; ++s) bf[s] = *(const h16x8*)(kp0 + (size_t)wave * 32 * OD_N + 16 * s);
        }
        for (int kt = wave; kt < nk32; kt += 8) {
            const int ktn = kt + 8 < nk32 ? kt + 8 : kt;
#pragma unroll
            for (int s = 0; s < 4; ++s) bn[s] = *(const h16x8*)(kp0 + (size_t)ktn * 32 * OD_N + 16 * s);
            const int kp = kt * 32 + r;
#pragma unroll 1
            for (int a = 0; a < 8; ++a) {
                f32x16 acc;
#pragma unroll
                for (int i = 0; i < 16; ++i) acc[i] = 0.f;
#pragma unroll
                for (int s = 0; s < 4; ++s) acc = mma32(*(const LAS h16x8*)(Aq + (32 * a + r) * 72 + 16 * s + 8 * hk), bf[s], acc);
#pragma unroll
                for (int qq = 0; qq < 2; ++qq) { const int qi = 4 * a + 2 * hk + qq;
                    const f32x4 w0 = *(const LAS f32x4*)(Wq + qi * 8), w1 = *(const LAS f32x4*)(Wq + qi * 8 + 4);
                    float sv = 0.f;
#pragma unroll
                    for (int e = 0; e < 4; ++e) { sv += w0[e] * fmaxf(acc[8 * qq + e], 0.f); sv += w1[e] * fmaxf(acc[8 * qq + 4 + e], 0.f); }
                    const int qpq = qblk * 32 + qi;
                    scw[(size_t)qi * 4096 + kp] = kp <= qpq ? sv : -INFINITY; }
            }
#pragma unroll
            for (int s = 0; s < 4; ++s) bf[s] = bn[s];
        }
        __syncthreads();
    }
#pragma unroll 1
    for (int ql = 0; ql < 4; ++ql) {
        const int qp = q0 + ql; const int tq = tb0 + qp;
        int lane2 = lane; asm volatile("" : "+v"(lane2));
        unsigned mlo, mhi;
        if (qp + 1 <= 256) {
            const int lo = lane2 * 64; const int nb = qp - lo + 1;
            const unsigned long long m = nb >= 64 ? ~0ull : (nb <= 0 ? 0ull : ((1ull << nb) - 1ull));
            mlo = (unsigned)m; mhi = (unsigned)(m >> 32);
        } else {
            unsigned u[64];
            const float* srow = scw + (size_t)(4 * wave + ql) * 4096 + lane2;
#pragma unroll
            for (int i = 0; i < 64; ++i) u[i] = __float_as_uint(srow[i * 64]);
            __builtin_amdgcn_sched_barrier(0);
#pragma unroll
            for (int i = 0; i < 64; ++i) { const int k = i * 64 + lane2; unsigned bb = u[i];
                if (bb == 0x80000000u) bb = 0u; bb = (bb & 0x80000000u) ? ~bb : (bb | 0x80000000u);
                u[i] = k <= qp ? bb : 0u; }
#define CNT_GE(cnt, x, c) do { int t_; asm volatile("v_cmp_ge_u32 vcc, %2, %3\n\ts_bcnt1_i32_b64 %1, vcc\n\ts_add_i32 %0, %0, %1" : "+s"(cnt), "=&s"(t_) : "v"(x), "v"(c) : "vcc", "scc"); } while (0)
#define CNT_GE4(cnt, x0, x1, x2, x3, c) do { int t_; unsigned long long m1_, m2_, m3_; asm volatile( \
                "v_cmp_ge_u32 vcc, %5, %9\n\tv_cmp_ge_u32_e64 %2, %6, %9\n\tv_cmp_ge_u32_e64 %3, %7, %9\n\tv_cmp_ge_u32_e64 %4, %8, %9\n\t" \
                "s_bcnt1_i32_b64 %1, vcc\n\ts_add_i32 %0, %0, %1\n\ts_bcnt1_i32_b64 %1, %2\n\ts_add_i32 %0, %0, %1\n\t" \
                "s_bcnt1_i32_b64 %1, %3\n\ts_add_i32 %0, %0, %1\n\ts_bcnt1_i32_b64 %1, %4\n\ts_add_i32 %0, %0, %1" \
                : "+s"(cnt), "=&s"(t_), "=&s"(m1_), "=&s"(m2_), "=&s"(m3_) : "v"(x0), "v"(x1), "v"(x2), "v"(x3), "v"(c) : "vcc", "scc"); } while (0)
            const int nreg = __builtin_amdgcn_readfirstlane((qp >> 6) + 1);
            unsigned thr = 0u;
            for (int bit = 31; bit >= 0; --bit) {
                const unsigned cand = thr | (1u << bit); int c = 0;
#pragma unroll
                for (int i = 0; i < 64; i += 4) if (i < nreg) CNT_GE4(c, u[i], u[i + 1], u[i + 2], u[i + 3], cand);
                if (c >= 256) thr = cand;
                if (c == 256) break;
            }
            int cge = 0, cgt = 0; const unsigned thr1 = thr + 1u;
#pragma unroll
            for (int i = 0; i < 64; ++i) { CNT_GE(cge, u[i], thr); CNT_GE(cgt, u[i], thr1); }
            const int need_eq = 256 - cgt, ceq = cge - cgt;
#pragma unroll
            for (int i = 0; i < 64; ++i) { const unsigned t1 = (unsigned)(i * 64 + lane2 + 1); unsigned rr;
                asm volatile("v_cmp_eq_u32 vcc, %1, %2\n\tv_cndmask_b32 %0, -1, %3, vcc\n\tv_cmp_gt_u32 vcc, %1, %2\n\tv_cndmask_b32_e64 %0, %0, 0, vcc" : "=&v"(rr) : "v"(u[i]), "v"(thr), "v"(t1) : "vcc");
                u[i] = rr; }
            int kcut = 0;
            if (ceq == need_eq) kcut = 4095;
            else {
                for (int bit = 11; bit >= 0; --bit) {
                    const unsigned test2 = (unsigned)(kcut + (1 << bit) - 1) + 2u; int c = 0;
#pragma unroll
                    for (int i = 0; i < 64; i += 4) CNT_GE4(c, u[i], u[i + 1], u[i + 2], u[i + 3], test2);
                    const int ties_le = (4096 - c) - cgt;
                    if (ties_le < need_eq) kcut += (1 << bit);
                }
            }
#undef CNT_GE
#undef CNT_GE4
            const unsigned kc1 = (unsigned)kcut + 1u;
            mlo = 0u; mhi = 0u;
#pragma unroll
            for (int i = 0; i < 64; ++i)
                asm volatile("v_cmp_le_u32 vcc, %2, %3\n\ts_nop 4\n\tv_writelane_b32 %0, vcc_lo, %4\n\tv_writelane_b32 %1, vcc_hi, %4" : "+v"(mlo), "+v"(mhi) : "v"(u[i]), "v"(kc1), "n"(i) : "vcc");
        }
        bm[(size_t)tq * 64 + lane2] = ((unsigned long long)mhi << 32) | mlo;
    }
}

__device__ __forceinline__ void dsa_attn_item(CParams& p, LAS unsigned char* lds, int b, int qb, int tid_in, int wave) {
    int tid = tid_in; asm volatile("" : "+v"(tid)); const int lane = tid & 63;
    unsigned char* R = p.ws + WS_R; const h16* proj = (const h16*)(R + R_PROJ); h16* y = (h16*)(R + R_Y);
    const unsigned long long* bm = (const unsigned long long*)(R + R_BM);
    const float* bd = (const float*)(p.ws + WS_BIASD) + 4 * 132;
    LAS h16* Ks0 = (LAS h16*)lds;
    LAS h16* Vt0 = (LAS h16*)(lds + 34816);
    LAS float* bdl = (LAS float*)(lds + 71680);
    const int hd = wave & 3, qs = wave >> 2, r = lane & 31, hh = lane >> 5;
    const int tb0 = b * SEQ; const int q0 = qb * 64 + 32 * qs;
    for (int i = tid; i < 4 * 132; i += NTHREADS) bdl[i] = bd[i];
    h16x8 qf[8];
#pragma unroll
    for (int s = 0; s < 8; ++s) qf[s] = *(const h16x8*)(proj + (size_t)(tb0 + q0 + r) * OD_N + 1536 + hd * 128 + 16 * s + 8 * hh);
    f32x16 o[4];
#pragma unroll
    for (int d = 0; d < 4; ++d)
#pragma unroll
        for (int i = 0; i < 16; ++i) o[d][i] = 0.f;
    float m_run = -INFINITY, l_run = 0.f;
    const int qp = q0 + r;
    const int vlo = r * 72 + ((hh ^ (r >> 3)) << 2), vhi = r * 72 + (((hh ^ (r >> 3)) ^ 2) << 2);
    const unsigned long long* bmq = bm + (size_t)(tb0 + qp) * 64;
    const LAS float* bdh = bdl + hd * 132;
    const int nkt = qb + 1;
    h16x8 pk[2], pv[2];
#pragma unroll
    for (int i = 0; i < 2; ++i) { const int key = i * 32 + (tid >> 4), ch = tid & 15;
        pk[i] = *(const h16x8*)(proj + (size_t)(tb0 + key) * OD_N + 2048 + ch * 8);
        pv[i] = *(const h16x8*)(proj + (size_t)(tb0 + key) * OD_N + 2176 + ch * 8); }
    ATT_STAGE(0, 2048, 2176, 1);
    unsigned long long mkn = bmq[0];
    __syncthreads();
    for (int kt = 0; kt < nkt; ++kt) {
        const int k0 = kt * 64; const int cur = kt & 1;
        const LAS h16* Ks = Ks0 + cur * 8704; const LAS h16* Vt = Vt0 + cur * 9216;
        const unsigned long long mk = mkn; mkn = bmq[kt + 1 < nkt ? kt + 1 : kt];
        if (kt + 1 < nkt) ATT_STAGE(cur ^ 1, 2048, 2176, kt + 2);
        if (__ballot(mk != 0ull) != 0ull) {
            const bool far = (k0 + 63 + 128 <= q0);
            const float bfar = bdh[128];
#pragma unroll
            for (int sub = 0; sub < 2; ++sub) {
                const unsigned mw = (unsigned)(mk >> (32 * sub));
                if (__ballot(mw != 0u) == 0ull) continue;
                f32x16 sc;
#pragma unroll
                for (int i = 0; i < 16; ++i) sc[i] = 0.f;
#pragma unroll
                for (int s = 0; s < 8; ++s) sc = mma32(*(const LAS h16x8*)(Ks + (32 * sub + r) * 136 + 16 * s + 8 * hh), qf[s], sc);
                float mx = -INFINITY;
#pragma unroll
                for (int i = 0; i < 16; ++i) { const int ko = (i & 3) + 8 * (i >> 2) + 4 * hh; const int dist = qp - (k0 + 32 * sub + ko);
                    float bias = bfar; if (!far) bias = bdh[dist < 0 ? 0 : (dist < 128 ? dist : 128)];
                    const float v = ((mw >> ko) & 1u) ? sc[i] + bias : -INFINITY; sc[i] = v; mx = fmaxf(mx, v); }
                mx = fmaxf(mx, __shfl_xor(mx, 32));
                const float m_new = fmaxf(m_run, mx);
                const float msafe = (m_new == -INFINITY) ? 0.f : m_new;
                const float alpha = __builtin_amdgcn_exp2f(m_run - msafe);
                const bool resc = __ballot(m_new > m_run) != 0ull;
                float ls = 0.f;
#pragma unroll
                for (int i = 0; i < 16; ++i) { const float e = __builtin_amdgcn_exp2f(sc[i] - msafe); sc[i] = e; ls += e; }
                ls += __shfl_xor(ls, 32);
                l_run = l_run * alpha + ls; m_run = m_new;
                if (resc) {
#pragma unroll
                    for (int d = 0; d < 4; ++d)
#pragma unroll
                        for (int i = 0; i < 16; ++i) o[d][i] *= alpha;
                }
#pragma unroll
                for (int s2 = 0; s2 < 2; ++s2) {
                    h16x8 pf;
#pragma unroll
                    for (int jj = 0; jj < 8; ++jj) pf[jj] = (h16)sc[8 * s2 + jj];
#pragma unroll
                    for (int d = 0; d < 4; ++d) {
                        const int coff = 32 * d * 72 + ((((sub << 1) | s2) ^ d) << 4);
                        const h16x4 lo = *(const LAS h16x4*)(Vt + vlo + coff), hi = *(const LAS h16x4*)(Vt + vhi + coff);
                        h16x8 vf; vf[0] = lo[0]; vf[1] = lo[1]; vf[2] = lo[2]; vf[3] = lo[3]; vf[4] = hi[0]; vf[5] = hi[1]; vf[6] = hi[2]; vf[7] = hi[3];
                        o[d] = mma32(vf, pf, o[d]);
                    }
                }
            }
        }
        __syncthreads();
    }
#undef ATT_STAGE
    const float inv = 1.f / l_run;
#pragma unroll
    for (int d = 0; d < 4; ++d)
#pragma unroll
        for (int i = 0; i < 16; ++i) { const int dv = 32 * d + (i & 3) + 8 * (i >> 2) + 4 * hh;
            y[(size_t)(tb0 + q0 + r) * D + 512 + hd * 128 + dv] = (h16)(o[d][i] * inv); }
}

__device__ __forceinline__ void phase_odd_attn(const int wid_s, CParams& p, int j, int layer, LAS unsigned char* lds) {
    int tid_ = TIDX; asm volatile("" : "+v"(tid_));
    const int tid = tid_, lane = tid & 63, wave = tid >> 6;
    for (int w = blockIdx.x; w < 256; w += gridDim.x) {
        const int xcd = w & 7, kx = w >> 3;
        {
#pragma unroll 1
            for (int i = 0; i < 4; ++i) { const int b = xcd + 8 * (i >> 1); const int qb = (i & 1) ? (63 - kx) : kx;
                dsa_select_item(p, lds, b, 2 * qb, tid, wave); dsa_select_item(p, lds, b, 2 * qb + 1, tid, wave);
                __syncthreads();
                dsa_attn_item(p, lds, b, qb, tid, wave);
                __syncthreads(); }
        }
        __syncthreads();
        {
#pragma unroll 1
            for (int i = 0; i < 8; ++i) { const int bh = xcd * 8 + i, b = bh >> 2, h = bh & 3; const int base = (kx + 8 * (i >> 1)) & 31; const int qb = (i & 1) ? (31 - base) : base;
                diff_attn_item(p, j, layer, lds, b, h, qb, tid, lane, wave); __syncthreads(); }
        }
    }
}

__device__ __forceinline__ void grid_barrier(unsigned* ctr, unsigned gen, const int wid_s) {
    __syncthreads();
    if (TIDX == 0) {
        __builtin_amdgcn_fence(__ATOMIC_RELEASE, "agent");
        asm volatile("s_waitcnt vmcnt(0)" ::: "memory");
        const unsigned target = gen * gridDim.x;
        __hip_atomic_fetch_add(ctr, 1u, __ATOMIC_RELAXED, __HIP_MEMORY_SCOPE_AGENT);
        unsigned spins = 0;
        while (__hip_atomic_load(ctr, __ATOMIC_RELAXED, __HIP_MEMORY_SCOPE_AGENT) < target) { __builtin_amdgcn_s_sleep(1); if (++spins > (1u << 24)) break; }
        __builtin_amdgcn_fence(__ATOMIC_ACQUIRE, "agent");
        asm volatile("s_waitcnt vmcnt(0)" ::: "memory");
    }
    __syncthreads();
}

__global__ void __launch_bounds__(NTHREADS, 2) mk_fwd(Params p_unused) {
    extern __shared__ __attribute__((aligned(16))) unsigned char lds_raw[];
    LAS unsigned char* lds = (LAS unsigned char*)lds_raw;
    cg::grid_group grid = cg::this_grid();
    const int wid_s = __builtin_amdgcn_readfirstlane((int)(threadIdx.x >> 6));
    int ph = 0;
    const int ph_lo = launder_kp()->ph_lo, ph_hi = launder_kp()->ph_hi;
#define PHASE_BEGIN if (ph >= ph_lo && ph < ph_hi) { CParams& p = *launder_kp(); unsigned char* ws = p.ws; h16* hb = (h16*)(ws + WS_HB); float* rsq = (float*)(ws + WS_RSQ); unsigned char* R = ws + WS_R; (void)hb; (void)rsq; (void)R;
#define PHASE_END   if (ph + 1 < ph_hi) { if (ph == 0) grid.sync(); else grid_barrier((unsigned*)(launder_kp()->ws + WS_MISC + 128), (unsigned)ph, wid_s); } } ++ph;

    PHASE_BEGIN phase_prep(wid_s, p, lds); PHASE_END

    for (int l = 0; l < DEPTH; ++l) {
        const int j = l >> 1;
        if ((l & 1) == 0) {
            PHASE_BEGIN {
                pg8::Gemm g{hb, (const h16*)(ws + WS_WIN_E + j * SZ_WIN_E), T, EV_N, D, D}; pg8::StaticOrder S; S.init(T, EV_N, gridDim.x, blockIdx.x);
                pg8::EpiStoreH E{(h16*)(R + R_PROJ), EV_N, rsq + (size_t)(2 * l) * T, 4, 12, (float*)(ws + WS_BA), nullptr};
                pg8::gemm_phase<pg8::EpiStoreH>(lds, g, S, E, wid_s);
            } PHASE_END
            PHASE_BEGIN phase_even_mix(wid_s, p, j, lds); PHASE_END
            PHASE_BEGIN phase_gdn_scan(wid_s, p, lds); PHASE_END
            PHASE_BEGIN phase_gdn_gate(wid_s, p, j); PHASE_END
            PHASE_BEGIN {
                pg8::Gemm g{(const h16*)(R + R_Y), (const h16*)(ws + WS_WOUT + l * SZ_WOUT), T, D, D, D}; pg8::StaticOrder S; S.init(T, D, gridDim.x, blockIdx.x);
                pg8::EpiResid E{hb, rsq + (size_t)(2 * l + 1) * T, nullptr};
                pg8::gemm_phase<pg8::EpiResid>(lds, g, S, E, wid_s);
            } PHASE_END
        } else {
            PHASE_BEGIN {
                pg8::Gemm g{hb, (const h16*)(ws + WS_WIN_O + j * SZ_WIN_O), T, OD_N, D, D}; pg8::StaticOrder S; S.init(T, OD_N, gridDim.x, blockIdx.x);
                pg8::EpiOddIn E{(h16*)(R + R_PROJ), OD_N, rsq + (size_t)(2 * l) * T, (const float*)(ws + WS_GTAB) + j * 512, (LAS float*)(lds + 131072)};
                pg8::gemm_phase<pg8::EpiOddIn>(lds, g, S, E, wid_s);
            } PHASE_END
            PHASE_BEGIN phase_odd_attn(wid_s, p, j, l, lds); PHASE_END
            PHASE_BEGIN {
                pg8::Gemm g{(const h16*)(R + R_Y), (const h16*)(ws + WS_WOUT + l * SZ_WOUT), T, D, D, D}; pg8::StaticOrder S; S.init(T, D, gridDim.x, blockIdx.x);
                pg8::EpiResid E{hb, rsq + (size_t)(2 * l + 1) * T, nullptr};
                pg8::gemm_phase<pg8::EpiResid>(lds, g, S, E, wid_s);
            } PHASE_END
        }
        PHASE_BEGIN {
            pg8::Gemm g{hb, (const h16*)(ws + WS_WUP + l * SZ_WUP), T, FF2, D, D}; pg8::StaticOrder S; S.init(T, FF2, gridDim.x, blockIdx.x);
            pg8::EpiUpFused E{(h16*)R, rsq + (size_t)(2 * l + 1) * T, p.in[21] + (size_t)l * 3 * FF2, p.in[22] + (size_t)l * FF2, (h16*)(ws + WS_HALO), (LAS float*)(lds + 131072)};
            pg8::gemm_phase<pg8::EpiUpFused>(lds, g, S, E, wid_s);
        } PHASE_END
        PHASE_BEGIN phase_ffn_fixup(wid_s, (h16*)R, (const h16*)(ws + WS_HALO), p.in[21] + (size_t)l * 3 * FF2, p.in[22] + (size_t)l * FF2); PHASE_END
        PHASE_BEGIN {
            pg8::Gemm g{(const h16*)R, (const h16*)(ws + WS_WDN + l * SZ_WDN), T, D, FF, FF}; pg8::StaticOrder S; S.init(T, D, gridDim.x, blockIdx.x);
            pg8::EpiResid E{hb, rsq + (size_t)(2 * l + 2) * T, (l == DEPTH - 1) ? p.out : nullptr};
            pg8::gemm_phase<pg8::EpiResid>(lds, g, S, E, wid_s);
        } PHASE_END
    }
}

extern "C" void kernel_launch(void* const* d_in, const int* in_sizes, int n_in, void* d_out, int out_size, void* d_ws, size_t ws_size, hipStream_t stream) {
    static int grid_blocks = 0;
    if (grid_blocks == 0) {
        if (ws_size < WS_END) { fprintf(stderr, "kernel_launch: workspace too small: %zu < %zu\n", ws_size, (size_t)WS_END); grid_blocks = -1; return; }
        int dev = 0, cus = 0, per_cu = 0;
        hipGetDevice(&dev);
        hipDeviceGetAttribute(&cus, hipDeviceAttributeMultiprocessorCount, dev);
        if (hipFuncSetAttribute((const void*)mk_fwd, hipFuncAttributeMaxDynamicSharedMemorySize, LDS_BYTES) != hipSuccess) { fprintf(stderr, "kernel_launch: hipFuncSetAttribute failed\n"); grid_blocks = -1; return; }
        hipOccupancyMaxActiveBlocksPerMultiprocessor(&per_cu, (const void*)mk_fwd, NTHREADS, LDS_BYTES);
        if (per_cu < 1) per_cu = 1;
        grid_blocks = cus * 1;
        fprintf(stderr, "kernel_launch: cus %d per_cu %d grid %d ws %zu need %zu\n", cus, per_cu, grid_blocks, ws_size, (size_t)WS_END);
    }
    if (grid_blocks < 0) return;
    if (hipMemsetAsync((char*)d_ws + WS_MISC + 128, 0, 64, stream) != hipSuccess) { fprintf(stderr, "kernel_launch: memset failed\n"); return; }
    Params p{};
    for (int i = 0; i < 24; ++i) p.in[i] = (const float*)d_in[i];
    p.out = (float*)d_out; p.ws = (unsigned char*)d_ws; p.ph_lo = 0; p.ph_hi = 1000;
    void* args[] = {&p};
    hipError_t e = hipLaunchCooperativeKernel((const void*)mk_fwd, dim3(grid_blocks), dim3(NTHREADS), args, LDS_BYTES, stream);
    if (e != hipSuccess) fprintf(stderr, "cooperative launch failed: %s (grid %d)\n", hipGetErrorString(e), grid_blocks);
}
```

```cpp
#include <hip/hip_runtime.h>
#include <hip/hip_cooperative_groups.h>
#include <cstdio>
namespace cg = cooperative_groups;

#define LAS __attribute__((address_space(3)))
typedef _Float16 h16;
typedef _Float16 h16x2 __attribute__((ext_vector_type(2)));
typedef _Float16 h16x4 __attribute__((ext_vector_type(4)));
typedef _Float16 h16x8 __attribute__((ext_vector_type(8)));
typedef float f32x2 __attribute__((ext_vector_type(2)));
typedef float f32x4 __attribute__((ext_vector_type(4)));
typedef float f32x16 __attribute__((ext_vector_type(16)));
typedef unsigned u32x4 __attribute__((ext_vector_type(4)));
typedef unsigned u32x2 __attribute__((ext_vector_type(2)));

constexpr int T = 65536, D = 1024, SEQ = 4096, NBATCH = 16, DEPTH = 4;
constexpr int EV_N = 3328, EV_SRC = 3080, OD_N = 3072, OD_SRC = 2888, FF = 2816, FF2 = 5632;
constexpr float EPS = 1e-6f;
constexpr int NTHREADS = 512;
constexpr int LDS_BYTES = 147456;

constexpr size_t SZ_WIN_E = (size_t)EV_N * D * 2, SZ_WIN_O = (size_t)OD_N * D * 2, SZ_WOUT = (size_t)D * D * 2, SZ_WUP = (size_t)FF2 * D * 2, SZ_WDN = (size_t)D * FF * 2;
constexpr size_t WS_WIN_E = 0;
constexpr size_t WS_WIN_O = WS_WIN_E + 2 * SZ_WIN_E;
constexpr size_t WS_WOUT = WS_WIN_O + 2 * SZ_WIN_O;
constexpr size_t WS_WUP = WS_WOUT + 4 * SZ_WOUT;
constexpr size_t WS_WDN = WS_WUP + 4 * SZ_WUP;
constexpr size_t WS_HB = WS_WDN + 4 * SZ_WDN;
constexpr size_t WS_RSQ = WS_HB + (size_t)T * D * 2;
constexpr size_t WS_BA = WS_RSQ + (size_t)9 * T * 4;
constexpr size_t WS_GWS = WS_BA + (size_t)T * 8 * 4;
constexpr size_t WS_BIASD = WS_GWS + (size_t)2 * 4 * 128 * 128 * 2;
constexpr size_t WS_MISC = WS_BIASD + 8 * 132 * 4;
constexpr size_t WS_GCL = WS_MISC + 256;
constexpr size_t WS_GTAB = WS_GCL + (size_t)(T / 64) * 4 * 4;
constexpr size_t WS_HALO = WS_GTAB + 2 * 4 * 128 * 4;
constexpr size_t WS_R = WS_HALO + (size_t)(T / 64) * 2 * FF2 * 2;
constexpr size_t R_PROJ = 0;
constexpr size_t R_Y = (size_t)T * EV_N * 2;
constexpr size_t R_G = R_Y + (size_t)T * D * 2;
constexpr size_t R_QG = R_G, R_KDT = R_G + (size_t)T * 512 * 2, R_INTRA = R_KDT + (size_t)T * 512 * 2;
constexpr size_t R_END = (size_t)T * FF2 * 2;
constexpr size_t WS_END = WS_R + R_END;

struct Params {
    const float* in[24];
    float* out;
    unsigned char* ws;
    int ph_lo, ph_hi;
};

typedef const __attribute__((address_space(4))) Params CParams;
__device__ __forceinline__ CParams* launder_kp() { CParams* q = (CParams*)__builtin_amdgcn_kernarg_segment_ptr(); asm volatile("" : "+s"(q)); return q; }

__device__ __forceinline__ int opaque_bid() { int b = blockIdx.x; asm volatile("" : "+v"(b)); return __builtin_amdgcn_readfirstlane(b); }

__device__ __forceinline__ int hw_lane() { return (int)__builtin_amdgcn_mbcnt_hi(~0u, __builtin_amdgcn_mbcnt_lo(~0u, 0u)); }
#define TIDX (wid_s * 64 + hw_lane())

__device__ __forceinline__ float wave_sum(float v) {
#pragma unroll
    for (int o = 32; o > 0; o >>= 1) v += __shfl_xor(v, o);
    return v;
}
__device__ __forceinline__ float gelu_tanh(float x) { const float z = 1.5957691216f * (x + 0.044715f * x * x * x); return x * __builtin_amdgcn_rcpf(1.f + __expf(-z)); }
__device__ __forceinline__ float silu_f(float x) { return x * __builtin_amdgcn_rcpf(1.f + __expf(-x)); }
__device__ __forceinline__ u32x4 pack8(const f32x4 a, const f32x4 b) {
    h16x8 h; h[0] = (h16)a[0]; h[1] = (h16)a[1]; h[2] = (h16)a[2]; h[3] = (h16)a[3]; h[4] = (h16)b[0]; h[5] = (h16)b[1]; h[6] = (h16)b[2]; h[7] = (h16)b[3];
    return __builtin_bit_cast(u32x4, h);
}

namespace pg8 {
constexpr int BM = 256, BK = 64, HALF = 128, HTB = HALF * BK * 2, STAGE_BYTES = 8 * HTB, NXCD = 8, WGM = 8;
__device__ __forceinline__ int lds_byte(int r, int c) { const int st = (r >> 4) * 2 + (c >> 5), rr = r & 15, cc = c & 31, ob = rr * 64 + cc * 2; return st * 1024 + (ob ^ (((ob >> 9) & 1) << 5)); }
__device__ __forceinline__ void stage_rc(int b, int& R, int& C) { const int st = b / 1024, sb = b % 1024, swz = sb ^ (((sb >> 9) & 1) << 5); R = (st >> 1) * 16 + swz / 64; C = (st & 1) * 32 + (swz % 64) / 2; }
__device__ __forceinline__ int perm32(int rho) { const int n = rho >> 4, i = rho & 15; return 8 * (i >> 2) + 4 * n + (i & 3); }
struct Unit { int pm, pn; };
struct Gemm { const h16* A; const h16* Bt; int M, N, K, lda; };
struct StaticOrder {
    int nM, nN, nwg, G, c;
    __device__ void init(int M, int N, int G_, int c_) { nM = M / BM; nN = N / BM; nwg = nM * nN; G = G_; c = c_; }
    __device__ bool next(int i, Unit& u) const {
        const long L = (long)i * G + c; if (L >= nwg) return false;
        int wgid = (int)L; { const int q = nwg / NXCD, r = nwg % NXCD, xcd = wgid % NXCD, off = wgid / NXCD; wgid = (xcd < r ? xcd * (q + 1) : r * (q + 1) + (xcd - r) * q) + off; }
        const int nig = WGM * nN, gid = wgid / nig, fm = gid * WGM, gsz = (nM - fm) < WGM ? (nM - fm) : WGM;
        u.pm = fm + ((wgid % nig) % gsz); u.pn = (wgid % nig) / gsz; return true;
    }
};

template <class Epi>
__device__ __forceinline__ void gemm_phase(LAS unsigned char* lds, const Gemm g, const StaticOrder& S, const Epi& E, const int wid_s) {
    int tid_ = TIDX; asm volatile("" : "+v"(tid_));
    const int tid = tid_, wid = __builtin_amdgcn_readfirstlane(tid >> 6), lane = tid & 63, wr = wid >> 2, wc = wid & 3, fr = lane & 15, fq = lane >> 4;
    const int K = g.K, nt = K / BK, lda = g.lda;
    unsigned voffA[2], voffB[2];
#pragma unroll
    for (int i = 0; i < 2; ++i) { int R, C; stage_rc(tid * 16 + i * 8192, R, C); const int Rb = Epi::PERM ? ((R & ~31) + perm32(R & 31)) : R;
        voffA[i] = (unsigned)(R * lda + C) * 2u; voffB[i] = (unsigned)(Rb * K + C) * 2u; }
    const size_t kstep = (size_t)(BK * 2);
    const size_t hstepA = (size_t)HALF * lda * 2, hstepB = (size_t)HALF * K * 2;
    const size_t tstepA = 2 * hstepA, tstepB = 2 * hstepB;
    const unsigned ldsw = (unsigned)wid * 1024u;
    const int aoff = lds_byte(wr * 64 + fr, fq * 8), boff = lds_byte(wc * 32 + fr, fq * 8);
#define PG8_SA(b, h) (((b) * 2 + (h)) * HTB)
#define PG8_SB(b, h) ((4 + (b) * 2 + (h)) * HTB)
#define PG8_STAGE(bufoff, gbase, voff) do { _Pragma("unroll") for (int _i = 0; _i < 2; ++_i) \
        __builtin_amdgcn_global_load_lds((const unsigned*)((const char*)(gbase) + (voff)[_i]), (LAS unsigned*)(lds + (bufoff) + ldsw + _i * 8192), 16, 0, 0); } while (0)
#define PG8_LDA(dst, b, h) do { _Pragma("unroll") for (int m = 0; m < 4; ++m) _Pragma("unroll") for (int k = 0; k < 2; ++k) dst[m][k] = *(const LAS h16x8*)(lds + PG8_SA(b, h) + aoff + m * 2048 + k * 1024); } while (0)
#define PG8_LDB(dst, b, h) do { _Pragma("unroll") for (int n = 0; n < 2; ++n) _Pragma("unroll") for (int k = 0; k < 2; ++k) dst[n][k] = *(const LAS h16x8*)(lds + PG8_SB(b, h) + boff + n * 2048 + k * 1024); } while (0)
#define PG8_MMA(ai, bj, At, Bt) do { __builtin_amdgcn_s_setprio(1); _Pragma("unroll") for (int m = 0; m < 4; ++m) _Pragma("unroll") for (int n = 0; n < 2; ++n) _Pragma("unroll") for (int k = 0; k < 2; ++k) \
        acc[ai][bj][m][n] = __builtin_amdgcn_mfma_f32_16x16x32_f16(Bt[n][k], At[m][k], acc[ai][bj][m][n], 0, 0, 0); __builtin_amdgcn_s_setprio(0); } while (0)
#define PG8_WAIT_V(n) asm volatile("s_waitcnt vmcnt(" #n ")" ::: "memory")
#define PG8_WAIT_L(n) asm volatile("s_waitcnt lgkmcnt(" #n ")" ::: "memory")
#define PG8_BAR __builtin_amdgcn_s_barrier()
#define PG8_SCHED __builtin_amdgcn_sched_barrier(0)
    Unit cur, nxt; int ui = 0;
    if (!S.next(0, cur)) return;
    f32x4 acc[2][2][4][2];
#pragma unroll
    for (int a = 0; a < 2; ++a)
#pragma unroll
        for (int b = 0; b < 2; ++b)
#pragma unroll
            for (int m = 0; m < 4; ++m)
#pragma unroll
                for (int n = 0; n < 2; ++n) acc[a][b][m][n] = (f32x4){0.f, 0.f, 0.f, 0.f};
    h16x8 At[4][2], B0[2][2], B1[2][2];
    const char* cA = (const char*)g.A + (size_t)cur.pm * tstepA; const char* cB = (const char*)g.Bt + (size_t)cur.pn * tstepB;
    PG8_STAGE(PG8_SB(0, 0), cB, voffB); PG8_STAGE(PG8_SA(0, 0), cA, voffA); PG8_STAGE(PG8_SB(0, 1), cB + hstepB, voffB); PG8_STAGE(PG8_SA(0, 1), cA + hstepA, voffA);
    if (wr == 1) PG8_BAR;
    PG8_WAIT_V(4); PG8_BAR;
    PG8_STAGE(PG8_SB(1, 0), cB + kstep, voffB); PG8_STAGE(PG8_SA(1, 0), cA + kstep, voffA); PG8_STAGE(PG8_SB(1, 1), cB + hstepB + kstep, voffB);
    PG8_WAIT_V(6); PG8_BAR;
    for (;;) {
        const bool has_next = S.next(ui + 1, nxt);
        const char* nA = has_next ? (const char*)g.A + (size_t)nxt.pm * tstepA : cA; const char* nB = has_next ? (const char*)g.Bt + (size_t)nxt.pn * tstepB : cB;
        for (int t = 0; t < nt; t += 2) {
            const bool last = (t == nt - 2);
            const char* a1 = cA + (size_t)(t + 1) * kstep;
            const char* a2 = last ? nA : cA + (size_t)(t + 2) * kstep; const char* b2 = last ? nB : cB + (size_t)(t + 2) * kstep;
            const char* a3 = a2 + kstep; const char* b3 = b2 + kstep;
            PG8_LDB(B0, 0, 0); PG8_SCHED; PG8_LDA(At, 0, 0); PG8_STAGE(PG8_SA(1, 1), a1 + hstepA, voffA);
            PG8_WAIT_L(8); PG8_BAR; PG8_WAIT_L(0); PG8_MMA(0, 0, At, B0); PG8_BAR; PG8_SCHED;
            PG8_LDB(B1, 0, 1); PG8_STAGE(PG8_SB(0, 0), b2, voffB);
            PG8_BAR; PG8_WAIT_L(0); PG8_MMA(0, 1, At, B1); PG8_BAR;
            PG8_LDA(At, 0, 1); PG8_STAGE(PG8_SA(0, 0), a2, voffA);
            PG8_BAR; PG8_WAIT_L(0); PG8_MMA(1, 0, At, B0); PG8_BAR; PG8_SCHED;
            PG8_STAGE(PG8_SB(0, 1), b2 + hstepB, voffB);
            PG8_WAIT_V(6); PG8_BAR; PG8_MMA(1, 1, At, B1); PG8_BAR;
            PG8_LDB(B0, 1, 0); PG8_SCHED; PG8_LDA(At, 1, 0); PG8_STAGE(PG8_SA(0, 1), a2 + hstepA, voffA);
            PG8_WAIT_L(8); PG8_BAR; PG8_WAIT_L(0); PG8_MMA(0, 0, At, B0); PG8_BAR; PG8_SCHED;
            PG8_LDB(B1, 1, 1); PG8_STAGE(PG8_SB(1, 0), b3, voffB);
            PG8_BAR; PG8_WAIT_L(0); PG8_MMA(0, 1, At, B1); PG8_BAR;
            PG8_LDA(At, 1, 1); PG8_STAGE(PG8_SA(1, 0), a3, voffA);
            PG8_BAR; PG8_WAIT_L(0); PG8_MMA(1, 0, At, B0); PG8_BAR; PG8_SCHED;
            PG8_STAGE(PG8_SB(1, 1), b3 + hstepB, voffB);
            PG8_WAIT_V(6); PG8_BAR; PG8_MMA(1, 1, At, B1); PG8_BAR;
        }
        E(acc, cur, wr, wc, fr, fq);
        if (!has_next) break;
#pragma unroll
        for (int a = 0; a < 2; ++a)
#pragma unroll
            for (int b = 0; b < 2; ++b)
#pragma unroll
                for (int m = 0; m < 4; ++m)
#pragma unroll
                    for (int n = 0; n < 2; ++n) acc[a][b][m][n] = (f32x4){0.f, 0.f, 0.f, 0.f};
        cur = nxt; cA = nA; cB = nB; ++ui;
    }
    PG8_WAIT_V(0);
    if (wr == 0) PG8_BAR;
    PG8_BAR;
#undef PG8_SA
#undef PG8_SB
#undef PG8_STAGE
#undef PG8_LDA
#undef PG8_LDB
#undef PG8_MMA
#undef PG8_WAIT_V
#undef PG8_WAIT_L
#undef PG8_BAR
#undef PG8_SCHED
}

struct EpiStoreH {
    static constexpr bool PERM = true;
    h16* O; int ldc; const float* rowsq; int gelu_tiles; int ba_tile; float* ba; h16* halo;
    __device__ __forceinline__ void operator()(const f32x4 (&acc)[2][2][4][2], const Unit& u, int wr, int wc, int fr, int fq) const {
        const int row0 = u.pm * BM + wr * 64 + fr, col0 = u.pn * BM + wc * 32 + 8 * fq;
        const bool dg = u.pn < gelu_tiles, isba = (u.pn == ba_tile);
        float rsv[2][4];
#pragma unroll
        for (int ai = 0; ai < 2; ++ai)
#pragma unroll
            for (int m = 0; m < 4; ++m) rsv[ai][m] = rowsq[row0 + ai * HALF + m * 16];
#pragma unroll
        for (int ai = 0; ai < 2; ++ai)
#pragma unroll
            for (int m = 0; m < 4; ++m) {
                const int r = row0 + ai * HALF + m * 16;
                const float rs = rsqrtf(rsv[ai][m] * (1.0f / 1024.0f) + EPS);
#pragma unroll
                for (int bj = 0; bj < 2; ++bj) {
                    f32x4 v0 = acc[ai][bj][m][0] * rs, v1 = acc[ai][bj][m][1] * rs;
                    if (isba) {
                        if (bj == 0 && wc == 0 && fq == 0) { *(f32x4*)(ba + (size_t)r * 8) = v0; *(f32x4*)(ba + (size_t)r * 8 + 4) = v1; }
                    } else {
                        if (dg) {
#pragma unroll
                            for (int j = 0; j < 4; ++j) { v0[j] = gelu_tanh(v0[j]); v1[j] = gelu_tanh(v1[j]); }
                        }
                        const u32x4 w = pack8(v0, v1);
                        *(u32x4*)(O + (size_t)r * ldc + col0 + bj * HALF) = w;
                        if (halo != nullptr && m == 3 && fr >= 14) *(u32x4*)(halo + ((size_t)(r >> 6) * 2 + (fr - 14)) * ldc + col0 + bj * HALF) = w;
                    }
                }
            }
    }
};
struct EpiResid {
    static constexpr bool PERM = false;
    h16* HB; float* rsq_next; float* OUT;
    __device__ __forceinline__ void operator()(const f32x4 (&acc)[2][2][4][2], const Unit& u, int wr, int wc, int fr, int fq) const {
        const int row0 = u.pm * BM + wr * 64 + fr, col0 = u.pn * BM + wc * 32 + 4 * fq;
        h16x4 hin[2][2], hnx[2][2];
#pragma unroll
        for (int bj = 0; bj < 2; ++bj)
#pragma unroll
            for (int n = 0; n < 2; ++n) hin[bj][n] = *(const h16x4*)(HB + (size_t)row0 * D + col0 + bj * HALF + n * 16);
#pragma unroll
        for (int g = 0; g < 8; ++g) {
            const int ai = g >> 2, m = g & 3;
            const int r = row0 + ai * HALF + m * 16; float ss = 0.f;
            if (g < 7) { const int rn = row0 + ((g + 1) >> 2) * HALF + ((g + 1) & 3) * 16;
#pragma unroll
                for (int bj = 0; bj < 2; ++bj)
#pragma unroll
                    for (int n = 0; n < 2; ++n) hnx[bj][n] = *(const h16x4*)(HB + (size_t)rn * D + col0 + bj * HALF + n * 16); }
#pragma unroll
            for (int bj = 0; bj < 2; ++bj)
#pragma unroll
                for (int n = 0; n < 2; ++n) {
                    const size_t o = (size_t)r * D + col0 + bj * HALF + n * 16;
                    f32x4 hv; hv[0] = (float)hin[bj][n][0]; hv[1] = (float)hin[bj][n][1]; hv[2] = (float)hin[bj][n][2]; hv[3] = (float)hin[bj][n][3];
                    hv += acc[ai][bj][m][n];
                    ss += hv[0] * hv[0] + hv[1] * hv[1] + hv[2] * hv[2] + hv[3] * hv[3];
                    if (OUT != nullptr) *(f32x4*)(OUT + o) = hv;
                    else { h16x4 hh; hh[0] = (h16)hv[0]; hh[1] = (h16)hv[1]; hh[2] = (h16)hv[2]; hh[3] = (h16)hv[3]; *(h16x4*)(HB + o) = hh; }
                }
            ss += __shfl_xor(ss, 16); ss += __shfl_xor(ss, 32);
            if (fq == 0) atomicAdd(rsq_next + r, ss);
#pragma unroll
            for (int bj = 0; bj < 2; ++bj)
#pragma unroll
                for (int n = 0; n < 2; ++n) hin[bj][n] = hnx[bj][n];
        }
    }
};

template <int CTRL> __device__ __forceinline__ float dppmov(const float oldv, const float src) {
    return __builtin_bit_cast(float, __builtin_amdgcn_update_dpp(__builtin_bit_cast(int, oldv), __builtin_bit_cast(int, src), CTRL, 0xf, 0xf, false)); }
struct EpiUpFused {
    static constexpr bool PERM = true;
    h16* act; const float* rowsq; const float* cw; const float* cb; h16* sb; LAS float* xch;
    __device__ __forceinline__ void operator()(const f32x4 (&acc_c)[2][2][4][2], const Unit& u, int wr, int wc, int fr, int fq) const {
        f32x4 (&acc)[2][2][4][2] = const_cast<f32x4 (&)[2][2][4][2]>(acc_c);
        const int row0 = u.pm * BM + wr * 64 + fr, jl = wc * 32 + 8 * fq, ch0 = u.pn * 128 + jl;
        float rsv[2][4];
#pragma unroll
        for (int ai = 0; ai < 2; ++ai)
#pragma unroll
            for (int m = 0; m < 4; ++m) rsv[ai][m] = rowsq[row0 + ai * HALF + m * 16];
#pragma unroll
        for (int ai = 0; ai < 2; ++ai)
#pragma unroll
            for (int m = 0; m < 4; ++m) { const float rs = rsqrtf(rsv[ai][m] * (1.0f / 1024.0f) + EPS);
#pragma unroll
                for (int bj = 0; bj < 2; ++bj)
#pragma unroll
                    for (int n = 0; n < 2; ++n) acc[ai][bj][m][n] *= rs; }
        if (fr >= 14) {
#pragma unroll
            for (int ai = 0; ai < 2; ++ai)
#pragma unroll
                for (int bj = 0; bj < 2; ++bj)
#pragma unroll
                    for (int n = 0; n < 2; ++n) *(LAS f32x4*)(xch + ((ai * 2 + wr) * 4 + wc) * 128 + (fr - 14) * 64 + bj * 32 + 8 * fq + 4 * n) = acc[ai][bj][3][n];
        }
        if ((wr == 1 && fr >= 14) || (wr == 0 && fr < 2)) {
            const int ai = wr, m = wr ? 3 : 0, srow = wr ? (2 + fr - 14) : fr;
#pragma unroll
            for (int bj = 0; bj < 2; ++bj) { const f32x4 a = wr ? acc[1][bj][3][0] : acc[0][bj][0][0], b = wr ? acc[1][bj][3][1] : acc[0][bj][0][1];
                *(u32x4*)(sb + ((size_t)u.pm * 4 + srow) * FF2 + u.pn * 256 + bj * 128 + jl) = pack8(a, b); }
            (void)ai; (void)m;
        }
        asm volatile("s_waitcnt lgkmcnt(0)" ::: "memory");
        __builtin_amdgcn_s_barrier(); __builtin_amdgcn_s_barrier();
        asm volatile("" ::: "memory");
#pragma unroll
        for (int n = 0; n < 2; ++n) {
            f32x4 wg[3], wv[3], bg, bv;
#pragma unroll
            for (int t = 0; t < 3; ++t) { wg[t] = *(const f32x4*)(cw + t * FF2 + ch0 + 4 * n); wv[t] = *(const f32x4*)(cw + t * FF2 + FF + ch0 + 4 * n); }
            bg = *(const f32x4*)(cb + ch0 + 4 * n); bv = *(const f32x4*)(cb + FF + ch0 + 4 * n);
#pragma unroll
            for (int ai = 0; ai < 2; ++ai) {
                f32x4 xpg = {0.f, 0.f, 0.f, 0.f}, xpv = {0.f, 0.f, 0.f, 0.f};
                const bool top = (ai == 0 && wr == 0);
                if (!top && fr >= 14) { const int ps = (wr == 1) ? ((ai * 2) * 4 + wc) : (((ai - 1) * 2 + 1) * 4 + wc);
                    xpg = *(const LAS f32x4*)(xch + ps * 128 + (fr - 14) * 64 + 8 * fq + 4 * n); xpv = *(const LAS f32x4*)(xch + ps * 128 + (fr - 14) * 64 + 32 + 8 * fq + 4 * n); }
#pragma unroll
                for (int m = 0; m < 4; ++m) {
                    const f32x4 cg = acc[ai][0][m][n], cv = acc[ai][1][m][n];
                    const f32x4 pg = m ? acc[ai][0][m - 1][n] : xpg, pv = m ? acc[ai][1][m - 1][n] : xpv;
                    h16x4 o;
#pragma unroll
                    for (int e = 0; e < 4; ++e) {
                        const float g1 = dppmov<0x111>(dppmov<0x121>(0.f, pg[e]), cg[e]), g2 = dppmov<0x112>(dppmov<0x122>(0.f, pg[e]), cg[e]);
                        const float v1 = dppmov<0x111>(dppmov<0x121>(0.f, pv[e]), cv[e]), v2 = dppmov<0x112>(dppmov<0x122>(0.f, pv[e]), cv[e]);
                        const float gate = wg[0][e] * g2 + wg[1][e] * g1 + wg[2][e] * cg[e] + bg[e];
                        const float val = wv[0][e] * v2 + wv[1][e] * v1 + wv[2][e] * cv[e] + bv[e];
                        o[e] = (h16)(silu_f(gate) * val);
                    }
                    *(h16x4*)(act + (size_t)(row0 + ai * HALF + m * 16) * FF + ch0 + 4 * n) = o;
                }
            }
        }
    }
};

struct EpiOddIn {
    static constexpr bool PERM = true;
    h16* O; int ldc; const float* rowsq; const float* gtab; LAS float* xch;
    __device__ __forceinline__ void operator()(const f32x4 (&acc_c)[2][2][4][2], const Unit& u, int wr, int wc, int fr, int fq) const {
        f32x4 (&acc)[2][2][4][2] = const_cast<f32x4 (&)[2][2][4][2]>(acc_c);
        const int row0 = u.pm * BM + wr * 64 + fr, col0 = u.pn * BM + wc * 32 + 8 * fq;
        const int pn = u.pn;
        const int kind0 = pn < 4 ? 1 : ((pn == 6 || pn == 7 || pn == 8) ? 2 : 0), kind1 = pn < 4 ? 1 : ((pn == 6 || pn == 7) ? 2 : 0);
        float rsv[2][4];
#pragma unroll
        for (int ai = 0; ai < 2; ++ai)
#pragma unroll
            for (int m = 0; m < 4; ++m) rsv[ai][m] = rowsq[row0 + ai * HALF + m * 16];
#pragma unroll
        for (int ai = 0; ai < 2; ++ai)
#pragma unroll
            for (int m = 0; m < 4; ++m) { const float rs = rsqrtf(rsv[ai][m] * (1.0f / 1024.0f) + EPS);
#pragma unroll
                for (int bj = 0; bj < 2; ++bj)
#pragma unroll
                    for (int n = 0; n < 2; ++n) acc[ai][bj][m][n] *= rs; }
        if (kind0 != 0) {
            const int kidx = pn < 2 ? 0 : (pn < 4 ? 1 : (pn < 8 ? 2 : 3));
            const int gcol = (kind0 == 1 ? 32 * (wc & 1) : 32 * wc) + 8 * fq;
            const f32x4 ga = *(const f32x4*)(gtab + kidx * 128 + gcol), gb = *(const f32x4*)(gtab + kidx * 128 + gcol + 4);
            const float gscale = 1.0f;
#pragma unroll
            for (int ai = 0; ai < 2; ++ai)
#pragma unroll
                for (int m = 0; m < 4; ++m)
#pragma unroll
                    for (int bj = 0; bj < 2; ++bj) { const f32x4 a = acc[ai][bj][m][0], b = acc[ai][bj][m][1];
                        float ss = (a[0] * a[0] + a[1] * a[1]) + (a[2] * a[2] + a[3] * a[3]) + (b[0] * b[0] + b[1] * b[1]) + (b[2] * b[2] + b[3] * b[3]);
                        ss += __shfl_xor(ss, 16); ss += __shfl_xor(ss, 32);
                        if (fq == 0) xch[((ai * HALF + wr * 64 + m * 16 + fr) * 2 + bj) * 4 + wc] = ss; }
            asm volatile("s_waitcnt lgkmcnt(0)" ::: "memory");
            __builtin_amdgcn_s_barrier(); __builtin_amdgcn_s_barrier();
            asm volatile("" ::: "memory");
#pragma unroll
            for (int ai = 0; ai < 2; ++ai)
#pragma unroll
                for (int m = 0; m < 4; ++m)
#pragma unroll
                    for (int bj = 0; bj < 2; ++bj) { const int kind = bj ? kind1 : kind0;
                        if (kind != 0) {
                            const f32x4 pp = *(const LAS f32x4*)(xch + ((ai * HALF + wr * 64 + m * 16 + fr) * 2 + bj) * 4);
                            const float sum = kind == 1 ? ((wc & 2) ? (pp[2] + pp[3]) : (pp[0] + pp[1])) : ((pp[0] + pp[1]) + (pp[2] + pp[3]));
                            const float gr = rsqrtf(sum * (kind == 1 ? (1.f / 64.f) : (1.f / 128.f)) + EPS) * gscale;
                            acc[ai][bj][m][0] *= ga * gr; acc[ai][bj][m][1] *= gb * gr; } }
        }
#pragma unroll
        for (int ai = 0; ai < 2; ++ai)
#pragma unroll
            for (int m = 0; m < 4; ++m) { const int r = row0 + ai * HALF + m * 16;
#pragma unroll
                for (int bj = 0; bj < 2; ++bj) *(u32x4*)(O + (size_t)r * ldc + col0 + bj * HALF) = pack8(acc[ai][bj][m][0], acc[ai][bj][m][1]); }
    }
};
}

__device__ __forceinline__ void map_col(int mode, int nd, int Nsrc, int& src, float& sc) {
    sc = 1.f;
    if (mode == 0) { src = nd < Nsrc ? nd : -1; }
    else if (mode == 1) { src = nd < 2560 ? nd : (nd < 3072 ? nd + 8 : (nd < 3080 ? nd - 512 : -1)); }
    else if (mode == 3) { const int pt = nd >> 8, rr = nd & 255; src = rr < 128 ? 128 * pt + rr : FF + 128 * pt + (rr - 128); }
    else { src = nd < Nsrc ? nd : -1; if (nd >= 2304 && nd < 2816) sc = 0.125f; if (nd >= 2880 && nd < 2888) sc = 0.35355339059f; }
}
__device__ __forceinline__ void conv_weight(const int wid_s, LAS float* tile, const float* __restrict__ W, int K, int Nsrc, h16* __restrict__ Wt, int Npad, const float* __restrict__ g, int mode) {
    int tid_ = TIDX; asm volatile("" : "+v"(tid_));
    const int tid = tid_, ktiles = K / 64, ntiles = Npad / 64;
    for (int t = blockIdx.x; t < ktiles * ntiles; t += gridDim.x) {
        const int nt = t / ktiles, kt = t % ktiles;
        {   const int n = tid & 63, nd = nt * 64 + n; int src; float sc; map_col(mode, nd, Nsrc, src, sc);
            const bool ok = src >= 0; const int sidx = ok ? src : 0; if (!ok) sc = 0.f;
            float vals[8], gv[8];
#pragma unroll
            for (int i = 0; i < 8; ++i) { const int k = i * 8 + (tid >> 6); vals[i] = W[(size_t)(kt * 64 + k) * Nsrc + sidx]; gv[i] = g ? g[kt * 64 + k] : 1.f; }
#pragma unroll
            for (int i = 0; i < 8; ++i) { const int k = i * 8 + (tid >> 6); tile[k * 65 + n] = vals[i] * sc * gv[i]; }
        }
        __syncthreads();
#pragma unroll
        for (int i = 0; i < 8; ++i) { const int n = i * 8 + (tid >> 6), k = tid & 63; Wt[(size_t)(nt * 64 + n) * K + kt * 64 + k] = (h16)tile[k * 65 + n]; }
        __syncthreads();
    }
}

__device__ __forceinline__ void phase_prep(const int wid_s, CParams& p, LAS unsigned char* lds) {
    int tid_ = TIDX; asm volatile("" : "+v"(tid_));
    const int tid = tid_, lane = tid & 63, wave = tid >> 6;
    unsigned char* ws = p.ws;
    LAS float* tile = (LAS float*)lds;
    const float* mix_g = p.in[2]; const float* ffn_g = p.in[19];
    for (int l = 0; l < DEPTH; ++l) {
        const int j = l >> 1;
        if ((l & 1) == 0) conv_weight(wid_s, tile, p.in[3] + (size_t)j * D * EV_SRC, D, EV_SRC, (h16*)(ws + WS_WIN_E + j * SZ_WIN_E), EV_N, mix_g + l * D, 1);
        else conv_weight(wid_s, tile, p.in[11] + (size_t)j * D * OD_SRC, D, OD_SRC, (h16*)(ws + WS_WIN_O + j * SZ_WIN_O), OD_N, mix_g + l * D, 2);
        const float* wo = (l & 1) == 0 ? p.in[4] + (size_t)j * D * D : p.in[12] + (size_t)j * D * D;
        conv_weight(wid_s, tile, wo, D, D, (h16*)(ws + WS_WOUT + l * SZ_WOUT), D, nullptr, 0);
        conv_weight(wid_s, tile, p.in[20] + (size_t)l * D * FF2, D, FF2, (h16*)(ws + WS_WUP + l * SZ_WUP), FF2, ffn_g + l * D, 3);
        conv_weight(wid_s, tile, p.in[23] + (size_t)l * FF * D, FF, D, (h16*)(ws + WS_WDN + l * SZ_WDN), D, nullptr, 0);
    }
    const float* x = p.in[0]; float* out = p.out; h16* hb = (h16*)(ws + WS_HB); float* rsq = (float*)(ws + WS_RSQ);
    const int bid8 = opaque_bid() * 8;
    for (int row = bid8 + wave; row < T; row += gridDim.x * 8) {
        float ss = 0.f;
        f32x4 xv4[4];
#pragma unroll
        for (int i = 0; i < 4; ++i) xv4[i] = *(const f32x4*)(x + (size_t)row * D + i * 256 + lane * 4);
#pragma unroll
        for (int i = 0; i < 4; ++i) {
            const size_t o = (size_t)row * D + i * 256 + lane * 4;
            const f32x4 v = xv4[i];
            h16x4 hh; hh[0] = (h16)v[0]; hh[1] = (h16)v[1]; hh[2] = (h16)v[2]; hh[3] = (h16)v[3]; *(h16x4*)(hb + o) = hh;
            ss += v[0] * v[0] + v[1] * v[1] + v[2] * v[2] + v[3] * v[3];
        }
        ss = wave_sum(ss);
        if (lane == 0) rsq[row] = ss;
    }
    for (size_t i = (size_t)opaque_bid() * NTHREADS + tid; i < (size_t)8 * T; i += (size_t)gridDim.x * NTHREADS) rsq[T + i] = 0.f;
    { const float* ws_ = p.in[5]; h16* gws = (h16*)(ws + WS_GWS);
      for (int i = opaque_bid() * NTHREADS + tid; i < 2 * 4 * 128 * 128; i += gridDim.x * NTHREADS) { const int s = i & 127, t = (i >> 7) & 127; gws[i] = (h16)(s <= t ? ws_[i] : 0.f); } }
    if (blockIdx.x == 0) {
        const float* rb = p.in[1]; float* bd = (float*)(ws + WS_BIASD);
        for (int i = tid; i < 8 * 129; i += NTHREADS) {
            const int h = i / 129, d = i % 129; int bucket;
            if (d < 16) bucket = d; else { const float nf = (float)d; int far = 16 + (int)(logf(nf / 16.0f) / 2.0794415416798357f * 16.0f); bucket = far < 31 ? far : 31; }
            bd[h * 132 + d] = rb[bucket * 8 + h] * 1.4426950408889634f;
        }
        { float* gt = (float*)(ws + WS_GTAB);
          for (int i = tid; i < 2 * 4 * 128; i += NTHREADS) { const int jj = i >> 9, kd = (i >> 7) & 3, c = i & 127;
              float v;
              if (kd == 0) v = p.in[13][jj * 64 + (c & 63)] * (0.125f * 1.4426950408889634f);
              else if (kd == 1) v = p.in[14][jj * 64 + (c & 63)];
              else if (kd == 2) v = p.in[17][jj * 128 + c] * (0.08838834764831845f * 1.4426950408889634f);
              else v = p.in[18][jj * 128 + c];
              gt[i] = v; } }
        if (tid < 2) { const float* dl = p.in[15] + tid * 4 * 64; float s1 = 0.f, s2 = 0.f; for (int i = 0; i < 64; ++i) { s1 += dl[i] * dl[64 + i]; s2 += dl[128 + i] * dl[192 + i]; }
            const int layer = 2 * tid + 1; const float li = 0.8f - 0.6f * expf(-0.3f * (float)layer);
            float* misc = (float*)(ws + WS_MISC); misc[tid * 2] = expf(s1) - expf(s2) + li; misc[tid * 2 + 1] = li; }
    }
}

__device__ __forceinline__ void phase_ffn_conv(const int wid_s, h16* up, const h16* halo, const float* __restrict__ cw, const float* __restrict__ cb) {
    const int nth = gridDim.x * NTHREADS;
    int tid_ = TIDX; asm volatile("" : "+v"(tid_));
    for (int idx = opaque_bid() * NTHREADS + tid_; idx < (T / 64) * (FF / 8); idx += nth) {
        const int cgp = idx % (FF / 8), rb = idx / (FF / 8), ch = cgp * 8, t0 = rb * 64;
        float wg[3][8], wv[3][8], bg[8], bv[8];
#pragma unroll
        for (int j = 0; j < 3; ++j)
#pragma unroll
            for (int c = 0; c < 8; ++c) { wg[j][c] = cw[j * FF2 + ch + c]; wv[j][c] = cw[j * FF2 + FF + ch + c]; }
#pragma unroll
        for (int c = 0; c < 8; ++c) { bg[c] = cb[ch + c]; bv[c] = cb[FF + ch + c]; }
        float g2[8], g1[8], v2[8], v1[8];
        if ((rb & 63) == 0) {
#pragma unroll
            for (int c = 0; c < 8; ++c) { g2[c] = g1[c] = v2[c] = v1[c] = 0.f; }
        } else {
            const h16* hp = halo + (size_t)(rb - 1) * 2 * FF2;
            const h16x8 a = *(const h16x8*)(hp + ch), b = *(const h16x8*)(hp + FF + ch), c2 = *(const h16x8*)(hp + FF2 + ch), d2 = *(const h16x8*)(hp + FF2 + FF + ch);
#pragma unroll
            for (int c = 0; c < 8; ++c) { g2[c] = (float)a[c]; v2[c] = (float)b[c]; g1[c] = (float)c2[c]; v1[c] = (float)d2[c]; }
        }
        h16* rp = up + (size_t)t0 * FF2 + ch;
#pragma unroll 1
        for (int r4 = 0; r4 < 16; ++r4) {
            h16x8 gcv[4], vcv[4];
#pragma unroll
            for (int q = 0; q < 4; ++q) { gcv[q] = *(const h16x8*)(rp + (size_t)q * FF2); vcv[q] = *(const h16x8*)(rp + (size_t)q * FF2 + FF); }
#pragma unroll
            for (int q = 0; q < 4; ++q) {
                h16x8 o;
#pragma unroll
                for (int c = 0; c < 8; ++c) {
                    const float g0 = (float)gcv[q][c], v0 = (float)vcv[q][c];
                    const float gate = wg[0][c] * g2[c] + wg[1][c] * g1[c] + wg[2][c] * g0 + bg[c];
                    const float val = wv[0][c] * v2[c] + wv[1][c] * v1[c] + wv[2][c] * v0 + bv[c];
                    o[c] = (h16)(silu_f(gate) * val);
                    g2[c] = g1[c]; g1[c] = g0; v2[c] = v1[c]; v1[c] = v0;
                }
                *(h16x8*)(rp + (size_t)q * FF2) = o;
            }
            rp += 4 * FF2;
        }
    }
}


__device__ __forceinline__ void phase_ffn_fixup(const int wid_s, h16* act, const h16* sb, const float* __restrict__ cw, const float* __restrict__ cb) {
    int tid_ = TIDX; asm volatile("" : "+v"(tid_));
    const int nth = gridDim.x * NTHREADS;
    for (int idx = opaque_bid() * NTHREADS + tid_; idx < (T / 256) * (FF / 8); idx += nth) {
        const int cgp = idx % (FF / 8), pm = idx / (FF / 8), ch = cgp * 8;
        if ((pm & 15) == 0) continue;
        const int col = 256 * (ch >> 7) + (ch & 127);
        const h16* s0 = sb + (size_t)pm * 4 * FF2 + col; const h16* sp = sb + (size_t)(pm - 1) * 4 * FF2 + col;
        const h16x8 g254 = *(const h16x8*)(sp + 2 * FF2), v254 = *(const h16x8*)(sp + 2 * FF2 + 128), g255 = *(const h16x8*)(sp + 3 * FF2), v255 = *(const h16x8*)(sp + 3 * FF2 + 128);
        const h16x8 g0 = *(const h16x8*)(s0), v0 = *(const h16x8*)(s0 + 128), g1 = *(const h16x8*)(s0 + FF2), v1 = *(const h16x8*)(s0 + FF2 + 128);
        h16x8 o0, o1;
#pragma unroll
        for (int c = 0; c < 8; ++c) {
            const float wg0 = cw[ch + c], wg1 = cw[FF2 + ch + c], wg2 = cw[2 * FF2 + ch + c], wv0 = cw[FF + ch + c], wv1 = cw[FF2 + FF + ch + c], wv2 = cw[2 * FF2 + FF + ch + c];
            const float bgc = cb[ch + c], bvc = cb[FF + ch + c];
            const float ga = wg0 * (float)g254[c] + wg1 * (float)g255[c] + wg2 * (float)g0[c] + bgc, va = wv0 * (float)v254[c] + wv1 * (float)v255[c] + wv2 * (float)v0[c] + bvc;
            const float gb = wg0 * (float)g255[c] + wg1 * (float)g0[c] + wg2 * (float)g1[c] + bgc, vb = wv0 * (float)v255[c] + wv1 * (float)v0[c] + wv2 * (float)v1[c] + bvc;
            o0[c] = (h16)(silu_f(ga) * va); o1[c] = (h16)(silu_f(gb) * vb);
        }
        *(h16x8*)(act + (size_t)(pm * 256) * FF + ch) = o0; *(h16x8*)(act + (size_t)(pm * 256 + 1) * FF + ch) = o1;
    }
}

__device__ __forceinline__ f32x4 mma16(const h16x8 a, const h16x8 b, const f32x4 c) { return __builtin_amdgcn_mfma_f32_16x16x32_f16(a, b, c, 0, 0, 0); }
constexpr int EM_QN = 0, EM_KN = 17408, EM_KB = 34816, EM_KBGT = 52224, EM_VBT = 70656, EM_LM = 89088, EM_M0 = 89088, EM_MT0 = 98304, EM_M1 = 107520, EM_MT1 = 116736, EM_TA0 = 125952, EM_TA1 = 135168, EM_SM = 144384;

__device__ __forceinline__ void phase_even_mix(const int wid_s, CParams& p, int j, LAS unsigned char* lds) {
    int tid_ = TIDX; asm volatile("" : "+v"(tid_));
    const int tid = tid_, lane = tid & 63, wave = tid >> 6, lr = lane & 15, lq = lane >> 4;
    unsigned char* ws = p.ws; unsigned char* R = ws + WS_R;
    h16* proj = (h16*)(R + R_PROJ); h16* y = (h16*)(R + R_Y);
    h16* qg = (h16*)(R + R_QG); h16* kdt = (h16*)(R + R_KDT); h16* intra = (h16*)(R + R_INTRA);
    const float* ba = (const float*)(ws + WS_BA); float* gcl = (float*)(ws + WS_GCL);
    const h16* gws = (const h16*)(ws + WS_GWS) + (size_t)j * 4 * 128 * 128;
    const float* bs = p.in[6] + j * 4 * 128;
    const float* cw = p.in[7] + (size_t)j * 4 * 1536;
    const float* alog = p.in[8] + j * 4; const float* dtb = p.in[9] + j * 4;
    LAS h16* Vt = (LAS h16*)(lds);
    LAS h16* Qn = (LAS h16*)(lds + EM_QN); LAS h16* Kn = (LAS h16*)(lds + EM_KN); LAS h16* KB = (LAS h16*)(lds + EM_KB);
    LAS h16* KBGt = (LAS h16*)(lds + EM_KBGT); LAS h16* VBt = (LAS h16*)(lds + EM_VBT);
    LAS h16* const Mb[2] = {(LAS h16*)(lds + EM_M0), (LAS h16*)(lds + EM_M1)}; LAS h16* const MTb[2] = {(LAS h16*)(lds + EM_MT0), (LAS h16*)(lds + EM_MT1)};
    LAS h16* const TAb[2] = {(LAS h16*)(lds + EM_TA0), (LAS h16*)(lds + EM_TA1)}; LAS h16* T16 = TAb[1];
    LAS float* ssq = (LAS float*)(lds + EM_SM); LAS float* betas = ssq + 128; LAS float* gcs = ssq + 192;
    for (int item = blockIdx.x; item < 2048; item += gridDim.x) {
        int tidi_ = tid_; asm volatile("" : "+v"(tidi_));
        const int tid = tidi_, lane = tid & 63, wave = tid >> 6, lr = lane & 15, lq = lane >> 4;
        const int g = item & 3, n = (item >> 2) & 31, b = item >> 7;
        const int t0 = b * SEQ + n * 128;
        {
            const int s = tid >> 2, q = tid & 3;
            float xv[32]; float sum = 0.f;
#pragma unroll
            for (int i = 0; i < 4; ++i) { const h16x8 v = *(const h16x8*)(proj + (size_t)(t0 + s) * EV_N + 512 + g * 128 + q * 32 + i * 8);
#pragma unroll
                for (int e = 0; e < 8; ++e) { xv[i * 8 + e] = (float)v[e]; sum += xv[i * 8 + e]; } }
            sum += __shfl_xor(sum, 1); sum += __shfl_xor(sum, 2);
            const float mean = sum * (1.f / 128.f); float var = 0.f;
#pragma unroll
            for (int i = 0; i < 32; ++i) { xv[i] -= mean; var += xv[i] * xv[i]; }
            var += __shfl_xor(var, 1); var += __shfl_xor(var, 2);
            const float rstd = rsqrtf(var * (1.f / 128.f) + EPS);
#pragma unroll
            for (int i = 0; i < 32; ++i) Vt[(q * 32 + i) * 136 + s] = (h16)(xv[i] * rstd);
        }
        __syncthreads();
        {
            const h16* gw = gws + (size_t)g * 128 * 128;
            h16x8 af[4];
#pragma unroll
            for (int ks = 0; ks < 4; ++ks) af[ks] = *(const h16x8*)(gw + (16 * wave + lr) * 128 + 32 * ks + 8 * lq);
            h16 uu[8][4]; float bsv[4];
#pragma unroll
            for (int r = 0; r < 4; ++r) bsv[r] = bs[g * 128 + 16 * wave + 4 * lq + r];
#pragma unroll
            for (int nt = 0; nt < 8; ++nt)
#pragma unroll
                for (int r = 0; r < 4; ++r) uu[nt][r] = proj[(size_t)(t0 + 16 * wave + 4 * lq + r) * EV_N + g * 128 + 16 * nt + lr];
#pragma unroll
            for (int nt = 0; nt < 8; ++nt) {
                f32x4 acc = {0.f, 0.f, 0.f, 0.f};
#pragma unroll
                for (int ks = 0; ks < 4; ++ks) if (32 * ks <= 16 * wave + 15) acc = mma16(af[ks], *(const LAS h16x8*)(Vt + (16 * nt + lr) * 136 + 32 * ks + 8 * lq), acc);
#pragma unroll
                for (int r = 0; r < 4; ++r) {
                    const int t = 16 * wave + 4 * lq + r, c = 16 * nt + lr;
                    const float mixed = acc[r] + bsv[r];
                    y[(size_t)(t0 + t) * D + g * 128 + c] = (h16)((float)uu[nt][r] * mixed);
                }
            }
        }
        __syncthreads();
        const int h = g;
#pragma unroll 1
        for (int cc = 0; cc < 2; ++cc) {
            int tidc_ = tidi_; asm volatile("" : "+v"(tidc_));
            const int tid = tidc_, lane = tid & 63, wave = tid >> 6, lr = lane & 15, lq = lane >> 4;
            const int tc0 = t0 + cc * 64; const int tin = (n * 128 + cc * 64);
            const int chh = (tc0 >> 6) * 4 + h;
            if (tid < 128) ssq[tid] = 0.f;
            __syncthreads();
            LAS h16* KDs = (LAS h16*)(lds + EM_LM);
#pragma unroll 1
            for (int pass = 0; pass < 2; ++pass) {
                if (tid < 384) {
                    const int gq = tid % 48, part = gq >> 4, c8 = (gq & 15) * 8, tok8 = (tid / 48) * 8;
                    float wv[4][8];
#pragma unroll
                    for (int jj = 0; jj < 4; ++jj)
#pragma unroll
                        for (int e = 0; e < 8; ++e) wv[jj][e] = cw[jj * 1536 + part * 512 + h * 128 + c8 + e];
                    const h16* xp = proj + (size_t)tc0 * EV_N + 1024 + part * 512 + h * 128 + c8;
                    const float glast = pass ? gcs[63] : 0.f;
                    h16x8 xa[11];
#pragma unroll
                    for (int r = 0; r < 11; ++r) { const int tt = tok8 - 3 + r; const bool okr = tin + tt >= 0;
                        xa[r] = *(const h16x8*)(xp + (long)(okr ? tt : 0) * EV_N);
                        if (!okr) {
#pragma unroll
                            for (int e = 0; e < 8; ++e) xa[r][e] = (h16)0.f; } }
#pragma unroll 1
                    for (int hf = 0; hf < 2; ++hf) {
                    h16x8 xr[7];
#pragma unroll
                    for (int r = 0; r < 7; ++r) xr[r] = hf ? xa[r + 4] : xa[r];
#pragma unroll
                    for (int i = 0; i < 4; ++i) {
                        const int t = tok8 + 4 * hf + i; float sq = 0.f; float cv[8];
#pragma unroll
                        for (int e = 0; e < 8; ++e) { const float a = wv[0][e] * (float)xr[i][e] + wv[1][e] * (float)xr[i + 1][e] + wv[2][e] * (float)xr[i + 2][e] + wv[3][e] * (float)xr[i + 3][e]; const float sv = silu_f(a); cv[e] = sv; sq += sv * sv; }
                        if (pass == 0) { if (part < 2) __hip_atomic_fetch_add(ssq + part * 64 + t, sq, __ATOMIC_RELAXED, __HIP_MEMORY_SCOPE_WORKGROUP); }
                        else if (part == 0) {
                            const float rn = rsqrtf(ssq[t] + EPS) * 0.08838834764831845f; const float eg = __expf(gcs[t]);
                            h16x8 a, bq;
#pragma unroll
                            for (int e = 0; e < 8; ++e) { const float v = cv[e] * rn; a[e] = (h16)v; bq[e] = (h16)(v * eg); }
                            *(LAS h16x8*)(Qn + t * 136 + c8) = a; *(h16x8*)(qg + (size_t)(tc0 + t) * 512 + h * 128 + c8) = bq;
                        } else if (part == 1) {
                            const float rn = rsqrtf(ssq[64 + t] + EPS); const float be = betas[t]; const float gt = gcs[t]; const float e1 = be * __expf(gt), e2 = __expf(glast - gt);
                            h16x8 a, bq;
#pragma unroll
                            for (int e = 0; e < 8; ++e) { const float v = cv[e] * rn; a[e] = (h16)v; bq[e] = (h16)(v * be); KBGt[(c8 + e) * 72 + t] = (h16)(v * e1); KDs[(c8 + e) * 72 + t] = (h16)(v * e2); }
                            *(LAS h16x8*)(Kn + t * 136 + c8) = a; *(LAS h16x8*)(KB + t * 136 + c8) = bq;
                        } else {
                            const float be = betas[t];
#pragma unroll
                            for (int e = 0; e < 8; ++e) VBt[(c8 + e) * 72 + t] = (h16)(cv[e] * be);
                        }
                    }
                    }
                } else if (tid < 448 && pass == 0) {
                    const int t = tid - 384;
                    const float braw = ba[(size_t)(tc0 + t) * 8 + h], araw = ba[(size_t)(tc0 + t) * 8 + 4 + h];
                    const float beta = 1.f / (1.f + __expf(-braw));
                    const float xx = araw + dtb[h];
                    const float sp = xx > 20.f ? xx : log1pf(__expf(xx));
                    float gt = -__expf(alog[h]) * sp;
#pragma unroll
                    for (int o = 1; o < 64; o <<= 1) { const float v = __shfl_up(gt, o); if (t >= o) gt += v; }
                    betas[t] = beta; gcs[t] = gt;
                    if (t == 63) gcl[chh] = gt;
                }
                __syncthreads();
            }
            for (int i = tid; i < 128 * 8; i += NTHREADS) { const int k = i >> 3, c8 = (i & 7) * 8; *(h16x8*)(kdt + ((size_t)chh * 128 + k) * 64 + c8) = *(const LAS h16x8*)(KDs + k * 72 + c8); }
            __syncthreads();
            {
                const int sel = wave >> 2, mt = wave & 3;
                const LAS h16* Am = sel ? Qn : KB;
                h16x8 af[4];
#pragma unroll
                for (int ks = 0; ks < 4; ++ks) af[ks] = *(const LAS h16x8*)(Am + (16 * mt + lr) * 136 + 32 * ks + 8 * lq);
#pragma unroll
                for (int nt = 0; nt < 4; ++nt) {
                    f32x4 acc = {0.f, 0.f, 0.f, 0.f};
#pragma unroll
                    for (int ks = 0; ks < 4; ++ks) acc = mma16(af[ks], *(const LAS h16x8*)(Kn + (16 * nt + lr) * 136 + 32 * ks + 8 * lq), acc);
                    const int jc = 16 * nt + lr; const float gj = gcs[jc];
                    h16x4 lt;
#pragma unroll
                    for (int r = 0; r < 4; ++r) { const int i = 16 * mt + 4 * lq + r;
                        const float dec = (jc <= i) ? __expf(gcs[i] - gj) : 0.f;
                        const h16 lv = (h16)((jc < i) ? acc[r] * dec : 0.f); lt[r] = lv;
                        if (sel == 0) Mb[0][i * 72 + jc] = lv;
                        else intra[((size_t)chh * 64 + i) * 64 + jc] = (h16)(acc[r] * dec); }
                    if (sel == 0) *(LAS h16x4*)(MTb[0] + jc * 72 + 16 * mt + 4 * lq) = lt;
                }
            }
            __syncthreads();
            {
                const int mt = wave >> 1, nt0 = 2 * (wave & 1);
                f32x4 tacc[2];
#pragma unroll
                for (int t = 0; t < 2; ++t) { const int jc = 16 * (nt0 + t) + lr;
#pragma unroll
                    for (int r = 0; r < 4; ++r) { const int i = 16 * mt + 4 * lq + r; const float v = ((i == jc) ? 1.f : 0.f) - (float)Mb[0][i * 72 + jc]; tacc[t][r] = v; TAb[0][i * 72 + jc] = (h16)v; } }
#define NEU_SQUARE(src, dst) do { _Pragma("unroll") for (int t = 0; t < 2; ++t) { f32x4 a_ = {0.f, 0.f, 0.f, 0.f}; \
                    _Pragma("unroll") for (int ks = 0; ks < 2; ++ks) a_ = mma16(*(const LAS h16x8*)(Mb[src] + (16 * mt + lr) * 72 + 32 * ks + 8 * lq), *(const LAS h16x8*)(MTb[src] + (16 * (nt0 + t) + lr) * 72 + 32 * ks + 8 * lq), a_); \
                    const int jc_ = 16 * (nt0 + t) + lr; h16x4 lt_; \
                    _Pragma("unroll") for (int r = 0; r < 4; ++r) { lt_[r] = (h16)a_[r]; Mb[dst][(16 * mt + 4 * lq + r) * 72 + jc_] = lt_[r]; } \
                    *(LAS h16x4*)(MTb[dst] + jc_ * 72 + 16 * mt + 4 * lq) = lt_; } } while (0)
                NEU_SQUARE(0, 1);
                __syncthreads();
#pragma unroll
                for (int st = 0; st < 5; ++st) {
                    const int mc = (st + 1) & 1, tc = st & 1;
#pragma unroll
                    for (int t = 0; t < 2; ++t) {
#pragma unroll
                        for (int ks = 0; ks < 2; ++ks) tacc[t] = mma16(*(const LAS h16x8*)(TAb[tc] + (16 * mt + lr) * 72 + 32 * ks + 8 * lq), *(const LAS h16x8*)(MTb[mc] + (16 * (nt0 + t) + lr) * 72 + 32 * ks + 8 * lq), tacc[t]);
                        const int jc = 16 * (nt0 + t) + lr;
#pragma unroll
                        for (int r = 0; r < 4; ++r) TAb[tc ^ 1][(16 * mt + 4 * lq + r) * 72 + jc] = (h16)tacc[t][r];
                    }
                    if (st < 4) NEU_SQUARE(mc, mc ^ 1);
                    __syncthreads();
                }
#undef NEU_SQUARE
            }
            {
                const int sel = wave >> 2, mt = wave & 3;
                const LAS h16* Bm = sel ? KBGt : VBt;
                h16x8 af[2];
#pragma unroll
                for (int ks = 0; ks < 2; ++ks) af[ks] = *(const LAS h16x8*)(T16 + (16 * mt + lr) * 72 + 32 * ks + 8 * lq);
#pragma unroll
                for (int nt = 0; nt < 8; ++nt) {
                    f32x4 acc = {0.f, 0.f, 0.f, 0.f};
#pragma unroll
                    for (int ks = 0; ks < 2; ++ks) acc = mma16(af[ks], *(const LAS h16x8*)(Bm + (16 * nt + lr) * 72 + 32 * ks + 8 * lq), acc);
#pragma unroll
                    for (int r = 0; r < 4; ++r) { const int i = 16 * mt + 4 * lq + r, d = 16 * nt + lr;
                        proj[(size_t)(tc0 + i) * EV_N + (sel ? 0 : 512) + h * 128 + d] = (h16)acc[r]; }
                }
            }
            __syncthreads();
        }
    }
}

__device__ __forceinline__ void phase_gdn_scan(const int wid_s, CParams& p, LAS unsigned char* lds) {
    int tid_ = TIDX; asm volatile("" : "+v"(tid_));
    const int tid = tid_, lane = tid & 63, wave = tid >> 6, lr = lane & 15, lq = lane >> 4;
    unsigned char* ws = p.ws; unsigned char* R = ws + WS_R;
    const h16* proj = (const h16*)(R + R_PROJ); h16* y = (h16*)(R + R_Y);
    const h16* qg = (const h16*)(R + R_QG); const h16* kdt = (const h16*)(R + R_KDT); const h16* intra = (const h16*)(R + R_INTRA);
    const float* gcl = (const float*)(ws + WS_GCL);
    LAS h16* St = (LAS h16*)lds;
    LAS h16* Vnt = (LAS h16*)(lds + 17408);
    for (int chain = blockIdx.x; chain < 256; chain += gridDim.x) {
        const int b = chain >> 4, h = (chain >> 2) & 3, sl = chain & 3;
        for (int i = tid; i < 32 * 136; i += NTHREADS) St[i] = (h16)0.f;
        f32x4 st[2] = {{0.f, 0.f, 0.f, 0.f}, {0.f, 0.f, 0.f, 0.f}};
        const int vt = wave & 1, wq = wave >> 1;
        __syncthreads();
        int cur = 0;
        h16x8 wf[4], qf[4], inf[2], kf[2][2]; h16x4 uu; float egl;
        h16x8 wfn[4], qfn[4], infn[2], kfn[2][2]; h16x4 uun; float egln;
#define SCAN_LOAD(WF, UU, QF, INF, KF, EGL, nn) do { const int tc_ = b * SEQ + (nn) * 64; const int ch_ = (tc_ >> 6) * 4 + h; \
            _Pragma("unroll") for (int ks = 0; ks < 4; ++ks) WF[ks] = *(const h16x8*)(proj + (size_t)(tc_ + 16 * wq + lr) * EV_N + h * 128 + 32 * ks + 8 * lq); \
            UU = *(const h16x4*)(proj + (size_t)(tc_ + 16 * wq + lr) * EV_N + 512 + h * 128 + 32 * sl + 16 * vt + 4 * lq); \
            _Pragma("unroll") for (int ks = 0; ks < 4; ++ks) QF[ks] = *(const h16x8*)(qg + (size_t)(tc_ + 16 * wq + lr) * 512 + h * 128 + 32 * ks + 8 * lq); \
            _Pragma("unroll") for (int ks = 0; ks < 2; ++ks) INF[ks] = *(const h16x8*)(intra + ((size_t)ch_ * 64 + 16 * wq + lr) * 64 + 32 * ks + 8 * lq); \
            _Pragma("unroll") for (int i = 0; i < 2; ++i) _Pragma("unroll") for (int ks = 0; ks < 2; ++ks) KF[i][ks] = *(const h16x8*)(kdt + ((size_t)ch_ * 128 + 16 * (2 * wq + i) + lr) * 64 + 32 * ks + 8 * lq); \
            EGL = gcl[ch_]; } while (0)
        SCAN_LOAD(wf, uu, qf, inf, kf, egl, 0);
        for (int n = 0; n < 64; ++n) {
            const int tc0 = b * SEQ + n * 64;
            const LAS h16* Sc = St + cur * (32 * 136); LAS h16* Sn = St + (cur ^ 1) * (32 * 136);
            { const int nn = n + 1 < 64 ? n + 1 : n; SCAN_LOAD(wfn, uun, qfn, infn, kfn, egln, nn); }
            {
                f32x4 acc = {0.f, 0.f, 0.f, 0.f};
#pragma unroll
                for (int ks = 0; ks < 4; ++ks) acc = mma16(*(const LAS h16x8*)(Sc + (16 * vt + lr) * 136 + 32 * ks + 8 * lq), wf[ks], acc);
#pragma unroll
                for (int r = 0; r < 4; ++r) Vnt[(16 * vt + 4 * lq + r) * 72 + 16 * wq + lr] = (h16)((float)uu[r] - acc[r]);
            }
            __syncthreads();
            {
                f32x4 acc = {0.f, 0.f, 0.f, 0.f};
#pragma unroll
                for (int ks = 0; ks < 4; ++ks) acc = mma16(qf[ks], *(const LAS h16x8*)(Sc + (16 * vt + lr) * 136 + 32 * ks + 8 * lq), acc);
#pragma unroll
                for (int ks = 0; ks < 2; ++ks) acc = mma16(inf[ks], *(const LAS h16x8*)(Vnt + (16 * vt + lr) * 72 + 32 * ks + 8 * lq), acc);
#pragma unroll
                for (int r = 0; r < 4; ++r) y[(size_t)(tc0 + 16 * wq + 4 * lq + r) * D + 512 + h * 128 + 32 * sl + 16 * vt + lr] = (h16)acc[r];
            }
#pragma unroll
            for (int i = 0; i < 2; ++i) {
                f32x4 acc = st[i] * __expf(egl);
#pragma unroll
                for (int ks = 0; ks < 2; ++ks) acc = mma16(*(const LAS h16x8*)(Vnt + (16 * vt + lr) * 72 + 32 * ks + 8 * lq), kf[i][ks], acc);
                st[i] = acc;
#pragma unroll
                for (int r = 0; r < 4; ++r) Sn[(16 * vt + 4 * lq + r) * 136 + 16 * (2 * wq + i) + lr] = (h16)acc[r];
            }
            __syncthreads();
            cur ^= 1;
#pragma unroll
            for (int ks = 0; ks < 4; ++ks) { wf[ks] = wfn[ks]; qf[ks] = qfn[ks]; }
#pragma unroll
            for (int ks = 0; ks < 2; ++ks) { inf[ks] = infn[ks]; kf[0][ks] = kfn[0][ks]; kf[1][ks] = kfn[1][ks]; }
            uu = uun; egl = egln;
        }
#undef SCAN_LOAD
    }
}

__device__ __forceinline__ void phase_gdn_gate(const int wid_s, CParams& p, int j) {
    int tid_ = TIDX; asm volatile("" : "+v"(tid_));
    const int tid = tid_, lane = tid & 63, wave = tid >> 6;
    unsigned char* R = p.ws + WS_R; const h16* proj = (const h16*)(R + R_PROJ); h16* y = (h16*)(R + R_Y);
    const float* gn = p.in[10] + j * 128;
    float gg[8];
#pragma unroll
    for (int e = 0; e < 8; ++e) gg[e] = gn[(8 * lane + e) & 127];
    const int bid8 = opaque_bid() * 8;
    for (int t = bid8 + wave; t < T; t += gridDim.x * 8) {
        h16x8* yp = (h16x8*)(y + (size_t)t * D + 512 + 8 * lane);
        h16x8 ov = *yp; const h16x8 zv = *(const h16x8*)(proj + (size_t)t * EV_N + 2560 + 8 * lane);
        float x[8], ss = 0.f;
#pragma unroll
        for (int e = 0; e < 8; ++e) { x[e] = (float)ov[e]; ss += x[e] * x[e]; }
        ss += __shfl_xor(ss, 1); ss += __shfl_xor(ss, 2); ss += __shfl_xor(ss, 4); ss += __shfl_xor(ss, 8);
        const float rs = rsqrtf(ss * (1.f / 128.f) + EPS);
#pragma unroll
        for (int e = 0; e < 8; ++e) ov[e] = (h16)(x[e] * rs * gg[e] * silu_f((float)zv[e]));
        *yp = ov;
    }
}

__device__ __forceinline__ f32x16 mma32(const h16x8 a, const h16x8 b, const f32x16 c) { return __builtin_amdgcn_mfma_f32_32x32x16_f16(a, b, c, 0, 0, 0); }
constexpr size_t R_SC = R_G;

__device__ __forceinline__ void phase_odd_prep(const int wid_s, CParams& p, int j) {
    int tid_ = TIDX; asm volatile("" : "+v"(tid_));
    const int tid = tid_, lane = tid & 63, wave = tid >> 6;
    h16* proj = (h16*)(p.ws + WS_R + R_PROJ);
    const float* gq = p.in[13] + j * 64; const float* gk = p.in[14] + j * 64; const float* gsq = p.in[17] + j * 128; const float* gsk = p.in[18] + j * 128;
    float fq[8], fk[8], fs[8];
#pragma unroll
    for (int e = 0; e < 8; ++e) { fq[e] = gq[(8 * lane + e) & 63] * (0.125f * 1.4426950408889634f); fk[e] = gk[(8 * lane + e) & 63]; fs[e] = gsq[(8 * lane + e) & 127] * (0.08838834764831845f * 1.4426950408889634f); }
    const float fk0 = gsk[2 * lane], fk1 = gsk[2 * lane + 1];
    const int bid8 = opaque_bid() * 8;
    for (int t = bid8 + wave; t < T; t += gridDim.x * 8) {
        h16* row = proj + (size_t)t * OD_N;
        h16x8 va = *(const h16x8*)(row + 8 * lane), vb = *(const h16x8*)(row + 512 + 8 * lane), vc = *(const h16x8*)(row + 1536 + 8 * lane);
        h16x2 vd = *(const h16x2*)(row + 2048 + 2 * lane);
        {   float x[8], ss = 0.f;
#pragma unroll
            for (int e = 0; e < 8; ++e) { x[e] = (float)va[e]; ss += x[e] * x[e]; }
            ss += __shfl_xor(ss, 1); ss += __shfl_xor(ss, 2); ss += __shfl_xor(ss, 4);
            const float rs = rsqrtf(ss * (1.f / 64.f) + EPS);
#pragma unroll
            for (int e = 0; e < 8; ++e) va[e] = (h16)(x[e] * rs * fq[e]);
            *(h16x8*)(row + 8 * lane) = va; }
        {   float x[8], ss = 0.f;
#pragma unroll
            for (int e = 0; e < 8; ++e) { x[e] = (float)vb[e]; ss += x[e] * x[e]; }
            ss += __shfl_xor(ss, 1); ss += __shfl_xor(ss, 2); ss += __shfl_xor(ss, 4);
            const float rs = rsqrtf(ss * (1.f / 64.f) + EPS);
#pragma unroll
            for (int e = 0; e < 8; ++e) vb[e] = (h16)(x[e] * rs * fk[e]);
            *(h16x8*)(row + 512 + 8 * lane) = vb; }
        {   float x[8], ss = 0.f;
#pragma unroll
            for (int e = 0; e < 8; ++e) { x[e] = (float)vc[e]; ss += x[e] * x[e]; }
            ss += __shfl_xor(ss, 1); ss += __shfl_xor(ss, 2); ss += __shfl_xor(ss, 4); ss += __shfl_xor(ss, 8);
            const float rs = rsqrtf(ss * (1.f / 128.f) + EPS);
#pragma unroll
            for (int e = 0; e < 8; ++e) vc[e] = (h16)(x[e] * rs * fs[e]);
            *(h16x8*)(row + 1536 + 8 * lane) = vc; }
        {   const float x0 = (float)vd[0], x1 = (float)vd[1];
            const float ss = wave_sum(x0 * x0 + x1 * x1);
            const float rs = rsqrtf(ss * (1.f / 128.f) + EPS);
            vd[0] = (h16)(x0 * rs * fk0); vd[1] = (h16)(x1 * rs * fk1);
            *(h16x2*)(row + 2048 + 2 * lane) = vd; }
    }
}

__device__ __forceinline__ void diff_attn_item(CParams& p, int j, int layer, LAS unsigned char* lds, int b, int h, int qb, int tid_in, int lane_in, int wave) {
    int tid = tid_in; asm volatile("" : "+v"(tid)); const int lane = tid & 63;
    unsigned char* R = p.ws + WS_R; const h16* proj = (const h16*)(R + R_PROJ); h16* y = (h16*)(R + R_Y);
    const float* bd = (const float*)(p.ws + WS_BIASD) + h * 132; const float* misc = (const float*)(p.ws + WS_MISC);
    LAS h16* Ks0 = (LAS h16*)lds;
    LAS h16* Vt0 = (LAS h16*)(lds + 34816);
    LAS float* bdl = (LAS float*)(lds + 71680);
    LAS float* Ox = (LAS float*)(lds + 73728);
    const int mp = wave >> 2, qs = wave & 3, r = lane & 31, hh = lane >> 5;
    const int tb0 = b * SEQ; const int q0 = qb * 128 + 32 * qs;
    if (tid < 129) bdl[tid] = bd[tid];
    h16x8 qf[4];
#pragma unroll
    for (int s = 0; s < 4; ++s) qf[s] = *(const h16x8*)(proj + (size_t)(tb0 + q0 + r) * OD_N + h * 128 + mp * 64 + 16 * s + 8 * hh);
    f32x16 o[4];
#pragma unroll
    for (int d = 0; d < 4; ++d)
#pragma unroll
        for (int i = 0; i < 16; ++i) o[d][i] = 0.f;
    float m_run = -INFINITY, l_run = 0.f;
    const int qp = q0 + r;
    const int vlo = r * 72 + ((hh ^ (r >> 3)) << 2), vhi = r * 72 + (((hh ^ (r >> 3)) ^ 2) << 2);
    const int nkt = 2 * (qb + 1);
    h16x8 pk[2], pv[2];
#pragma unroll
    for (int i = 0; i < 2; ++i) { const int key = i * 32 + (tid >> 4), ch = tid & 15;
        pk[i] = *(const h16x8*)(proj + (size_t)(tb0 + key) * OD_N + 512 + h * 128 + ch * 8);
        pv[i] = *(const h16x8*)(proj + (size_t)(tb0 + key) * OD_N + 1024 + h * 128 + ch * 8); }
#define ATT_STAGE(buf, KC, VC, ktn) do { LAS h16* Kd_ = Ks0 + (buf) * 8704; LAS h16* Vd_ = Vt0 + (buf) * 9216; \
        _Pragma("unroll") for (int i = 0; i < 2; ++i) { const int key = i * 32 + (tid >> 4), ch = tid & 15; \
            *(LAS h16x8*)(Kd_ + key * 136 + ch * 8) = pk[i]; \
            _Pragma("unroll") for (int e = 0; e < 8; ++e) Vd_[(ch * 8 + e) * 72 + ((((key >> 2) ^ ch) << 2) | (key & 3))] = pv[i][e]; } \
        const int kn_ = ((ktn) < nkt ? (ktn) : nkt - 1) * 64; \
        _Pragma("unroll") for (int i = 0; i < 2; ++i) { const int key = i * 32 + (tid >> 4), ch = tid & 15; \
            pk[i] = *(const h16x8*)(proj + (size_t)(tb0 + kn_ + key) * OD_N + (KC) + ch * 8); \
            pv[i] = *(const h16x8*)(proj + (size_t)(tb0 + kn_ + key) * OD_N + (VC) + ch * 8); } } while (0)
    ATT_STAGE(0, 512 + h * 128, 1024 + h * 128, 1);
    __syncthreads();
    for (int kt = 0; kt < nkt; ++kt) {
        const int k0 = kt * 64; const int cur = kt & 1;
        const LAS h16* Ks = Ks0 + cur * 8704; const LAS h16* Vt = Vt0 + cur * 9216;
        if (kt + 1 < nkt) ATT_STAGE(cur ^ 1, 512 + h * 128, 1024 + h * 128, kt + 2);
        if (!(k0 > q0 + 31)) {
        f32x16 sc[2];
#pragma unroll
        for (int sub = 0; sub < 2; ++sub) {
#pragma unroll
            for (int i = 0; i < 16; ++i) sc[sub][i] = 0.f;
#pragma unroll
            for (int s = 0; s < 4; ++s) sc[sub] = mma32(*(const LAS h16x8*)(Ks + (32 * sub + r) * 136 + mp * 64 + 16 * s + 8 * hh), qf[s], sc[sub]);
        }
        float mx = -INFINITY;
        if (k0 + 63 + 128 <= q0) {
            const float bfar = bdl[128];
#pragma unroll
            for (int sub = 0; sub < 2; ++sub)
#pragma unroll
                for (int i = 0; i < 16; ++i) { sc[sub][i] += bfar; mx = fmaxf(mx, sc[sub][i]); }
        } else {
#pragma unroll
            for (int sub = 0; sub < 2; ++sub)
#pragma unroll
                for (int i = 0; i < 16; ++i) { const int kp = k0 + 32 * sub + (i & 3) + 8 * (i >> 2) + 4 * hh; const int dist = qp - kp;
                    const float v = dist < 0 ? -INFINITY : sc[sub][i] + bdl[dist < 128 ? dist : 128]; sc[sub][i] = v; mx = fmaxf(mx, v); }
        }
        mx = fmaxf(mx, __shfl_xor(mx, 32));
        const float m_new = fmaxf(m_run, mx);
        const float alpha = __builtin_amdgcn_exp2f(m_run - m_new);
        const bool resc = __ballot(m_new > m_run) != 0ull;
        float ls = 0.f;
#pragma unroll
        for (int sub = 0; sub < 2; ++sub)
#pragma unroll
            for (int i = 0; i < 16; ++i) { const float e = __builtin_amdgcn_exp2f(sc[sub][i] - m_new); sc[sub][i] = e; ls += e; }
        ls += __shfl_xor(ls, 32);
        l_run = l_run * alpha + ls; m_run = m_new;
        if (resc) {
#pragma unroll
            for (int d = 0; d < 4; ++d)
#pragma unroll
                for (int i = 0; i < 16; ++i) o[d][i] *= alpha;
        }
#pragma unroll
        for (int sub = 0; sub < 2; ++sub)
#pragma unroll
            for (int s2 = 0; s2 < 2; ++s2) {
                h16x8 pf;
#pragma unroll
                for (int jj = 0; jj < 8; ++jj) pf[jj] = (h16)sc[sub][8 * s2 + jj];
#pragma unroll
                for (int d = 0; d < 4; ++d) {
                    const int coff = 32 * d * 72 + ((((sub << 1) | s2) ^ d) << 4);
                    const h16x4 lo = *(const LAS h16x4*)(Vt + vlo + coff), hi = *(const LAS h16x4*)(Vt + vhi + coff);
                    h16x8 vf; vf[0] = lo[0]; vf[1] = lo[1]; vf[2] = lo[2]; vf[3] = lo[3]; vf[4] = hi[0]; vf[5] = hi[1]; vf[6] = hi[2]; vf[7] = hi[3];
                    o[d] = mma32(vf, pf, o[d]);
                }
            }
        }
        __syncthreads();
    }
    const float inv = 1.f / l_run;
    if (mp == 1) {
#pragma unroll
        for (int d = 0; d < 4; ++d)
#pragma unroll
            for (int i = 0; i < 16; ++i) Ox[(qs * 64 + d * 16 + i) * 64 + lane] = o[d][i] * inv;
    }
    __syncthreads();
    if (mp == 0) {
        const float lam = misc[j * 2], li = misc[j * 2 + 1];
        const float* sg = p.in[16] + j * 128;
        float ss = 0.f;
#pragma unroll
        for (int d = 0; d < 4; ++d)
#pragma unroll
            for (int i = 0; i < 16; ++i) { const float v = o[d][i] * inv - lam * Ox[(qs * 64 + d * 16 + i) * 64 + lane]; o[d][i] = v; ss += v * v; }
        ss += __shfl_xor(ss, 32);
        const float rs = rsqrtf(ss * (1.f / 128.f) + EPS) * (1.f - li);
#pragma unroll
        for (int d = 0; d < 4; ++d)
#pragma unroll
            for (int i = 0; i < 16; ++i) { const int dv = 32 * d + (i & 3) + 8 * (i >> 2) + 4 * hh;
                y[(size_t)(tb0 + q0 + r) * D + h * 128 + dv] = (h16)(o[d][i] * rs * sg[dv]); }
    }
}

constexpr size_t R_BM = (size_t)T * OD_N * 2;
__device__ __forceinline__ void dsa_select_item(CParams& p, LAS unsigned char* lds, int b, int qblk, int tid_in, int wave) {
    int tid = tid_in; asm volatile("" : "+v"(tid)); const int lane = tid & 63;
    unsigned char* R = p.ws + WS_R; const h16* proj = (const h16*)(R + R_PROJ);
    unsigned long long* bm = (unsigned long long*)(R + R_BM);
    float* scw = (float*)(R + R_SC) + (size_t)blockIdx.x * 32 * 4096;
    const int tb0 = b * SEQ; const int q0 = qblk * 32 + 4 * wave;
    {
        LAS h16* Aq = (LAS h16*)(lds + 40960);
        LAS float* Wq = (LAS float*)(lds + 77824);
        __syncthreads();
        {   const int Rr = tid >> 1, half = tid & 1, a = Rr >> 5, r = Rr & 31;
            const int rho = (r & 3) + 4 * (r >> 3), hd = rho & 7, qloc = 2 * ((r >> 2) & 1) + (rho >> 3);
            const h16* src = proj + (size_t)(tb0 + qblk * 32 + 4 * a + qloc) * OD_N + 2304 + hd * 64 + half * 32;
#pragma unroll
            for (int c = 0; c < 4; ++c) *(LAS h16x8*)(Aq + Rr * 72 + half * 32 + c * 8) = *(const h16x8*)(src + c * 8);
            if (tid < 256) Wq[tid] = (float)proj[(size_t)(tb0 + qblk * 32 + (tid >> 3)) * OD_N + 2880 + (tid & 7)];
        }
        __syncthreads();
        const int r = lane & 31, hk = lane >> 5;
        const int nk32 = qblk + 1;
        const h16* kp0 = proj + (size_t)(tb0 + r) * OD_N + 2816 + 8 * hk;
        h16x8 bf[4], bn[4];
        if (wave < nk32) {
#pragma unroll
            for (int s = 0; s < 4; ++s) bf[s] = *(const h16x8*)(kp0 + (size_t)wave * 32 * OD_N + 16 * s);
        }
        for (int kt = wave; kt < nk32; kt += 8) {
            const int ktn = kt + 8 < nk32 ? kt + 8 : kt;
#pragma unroll
            for (int s = 0; s < 4; ++s) bn[s] = *(const h16x8*)(kp0 + (size_t)ktn * 32 * OD_N + 16 * s);
            const int kp = kt * 32 + r;
#pragma unroll 1
            for (int a = 0; a < 8; ++a) {
                f32x16 acc;
#pragma unroll
                for (int i = 0; i < 16; ++i) acc[i] = 0.f;
#pragma unroll
                for (int s = 0; s < 4; ++s) acc = mma32(*(const LAS h16x8*)(Aq + (32 * a + r) * 72 + 16 * s + 8 * hk), bf[s], acc);
#pragma unroll
                for (int qq = 0; qq < 2; ++qq) { const int qi = 4 * a + 2 * hk + qq;
                    const f32x4 w0 = *(const LAS f32x4*)(Wq + qi * 8), w1 = *(const LAS f32x4*)(Wq + qi * 8 + 4);
                    float sv = 0.f;
#pragma unroll
                    for (int e = 0; e < 4; ++e) { sv += w0[e] * fmaxf(acc[8 * qq + e], 0.f); sv += w1[e] * fmaxf(acc[8 * qq + 4 + e], 0.f); }
                    const int qpq = qblk * 32 + qi;
                    scw[(size_t)qi * 4096 + kp] = kp <= qpq ? sv : -INFINITY; }
            }
#pragma unroll
            for (int s = 0; s < 4; ++s) bf[s] = bn[s];
        }
        __syncthreads();
    }
    unsigned un[64];
    {   const float* s0 = scw + (size_t)(4 * wave) * 4096 + lane;
#pragma unroll
        for (int i = 0; i < 64; ++i) un[i] = __float_as_uint(s0[i * 64]); }
#pragma unroll 1
    for (int ql = 0; ql < 4; ++ql) {
        const int qp = q0 + ql; const int tq = tb0 + qp;
        int lane2 = lane; asm volatile("" : "+v"(lane2));
        unsigned mlo, mhi;
        unsigned u[64];
#pragma unroll
        for (int i = 0; i < 64; ++i) u[i] = un[i];
        if (ql < 3) { const float* sn = scw + (size_t)(4 * wave + ql + 1) * 4096 + lane2;
#pragma unroll
            for (int i = 0; i < 64; ++i) un[i] = __float_as_uint(sn[i * 64]); }
        __builtin_amdgcn_sched_barrier(0);
        if (qp + 1 <= 256) {
            const int lo = lane2 * 64; const int nb = qp - lo + 1;
            const unsigned long long m = nb >= 64 ? ~0ull : (nb <= 0 ? 0ull : ((1ull << nb) - 1ull));
            mlo = (unsigned)m; mhi = (unsigned)(m >> 32);
        } else {
#pragma unroll
            for (int i = 0; i < 64; ++i) { const int k = i * 64 + lane2; unsigned bb = u[i];
                if (bb == 0x80000000u) bb = 0u; bb = (bb & 0x80000000u) ? ~bb : (bb | 0x80000000u);
                u[i] = k <= qp ? bb : 0u; }
#define CNT_GE(cnt, x, c) do { int t_; asm volatile("v_cmp_ge_u32 vcc, %2, %3\n\ts_bcnt1_i32_b64 %1, vcc\n\ts_add_i32 %0, %0, %1" : "+s"(cnt), "=&s"(t_) : "v"(x), "v"(c) : "vcc", "scc"); } while (0)
#define CNT_GE4(cnt, x0, x1, x2, x3, c) do { int t_; unsigned long long m1_, m2_, m3_; asm volatile( \
                "v_cmp_ge_u32 vcc, %5, %9\n\tv_cmp_ge_u32_e64 %2, %6, %9\n\tv_cmp_ge_u32_e64 %3, %7, %9\n\tv_cmp_ge_u32_e64 %4, %8, %9\n\t" \
                "s_bcnt1_i32_b64 %1, vcc\n\ts_add_i32 %0, %0, %1\n\ts_bcnt1_i32_b64 %1, %2\n\ts_add_i32 %0, %0, %1\n\t" \
                "s_bcnt1_i32_b64 %1, %3\n\ts_add_i32 %0, %0, %1\n\ts_bcnt1_i32_b64 %1, %4\n\ts_add_i32 %0, %0, %1" \
                : "+s"(cnt), "=&s"(t_), "=&s"(m1_), "=&s"(m2_), "=&s"(m3_) : "v"(x0), "v"(x1), "v"(x2), "v"(x3), "v"(c) : "vcc", "scc"); } while (0)
            const int nreg = __builtin_amdgcn_readfirstlane((qp >> 6) + 1);
            unsigned thr = 0u;
            for (int bit = 31; bit >= 0; --bit) {
                const unsigned cand = thr | (1u << bit); int c = 0;
#pragma unroll
                for (int i = 0; i < 64; i += 4) if (i < nreg) CNT_GE4(c, u[i], u[i + 1], u[i + 2], u[i + 3], cand);
                if (c >= 256) thr = cand;
                if (c == 256) break;
            }
            int cge = 0, cgt = 0; const unsigned thr1 = thr + 1u;
#pragma unroll
            for (int i = 0; i < 64; ++i) { CNT_GE(cge, u[i], thr); CNT_GE(cgt, u[i], thr1); }
            const int need_eq = 256 - cgt, ceq = cge - cgt;
#pragma unroll
            for (int i = 0; i < 64; ++i) { const unsigned t1 = (unsigned)(i * 64 + lane2 + 1); unsigned rr;
                asm volatile("v_cmp_eq_u32 vcc, %1, %2\n\tv_cndmask_b32 %0, -1, %3, vcc\n\tv_cmp_gt_u32 vcc, %1, %2\n\tv_cndmask_b32_e64 %0, %0, 0, vcc" : "=&v"(rr) : "v"(u[i]), "v"(thr), "v"(t1) : "vcc");
                u[i] = rr; }
            int kcut = 0;
            if (ceq == need_eq) kcut = 4095;
            else {
                for (int bit = 11; bit >= 0; --bit) {
                    const unsigned test2 = (unsigned)(kcut + (1 << bit) - 1) + 2u; int c = 0;
#pragma unroll
                    for (int i = 0; i < 64; i += 4) CNT_GE4(c, u[i], u[i + 1], u[i + 2], u[i + 3], test2);
                    const int ties_le = (4096 - c) - cgt;
                    if (ties_le < need_eq) kcut += (1 << bit);
                }
            }
#undef CNT_GE
#undef CNT_GE4
            const unsigned kc1 = (unsigned)kcut + 1u;
            mlo = 0u; mhi = 0u;
#pragma unroll
            for (int i = 0; i < 64; ++i)
                asm volatile("v_cmp_le_u32 vcc, %2, %3\n\ts_nop 4\n\tv_writelane_b32 %0, vcc_lo, %4\n\tv_writelane_b32 %1, vcc_hi, %4" : "+v"(mlo), "+v"(mhi) : "v"(u[i]), "v"(kc1), "n"(i) : "vcc");
        }
        bm[(size_t)tq * 64 + lane2] = ((unsigned long long)mhi << 32) | mlo;
    }
}

__device__ __forceinline__ void dsa_attn_item(CParams& p, LAS unsigned char* lds, int b, int qb, int tid_in, int wave) {
    int tid = tid_in; asm volatile("" : "+v"(tid)); const int lane = tid & 63;
    unsigned char* R = p.ws + WS_R; const h16* proj = (const h16*)(R + R_PROJ); h16* y = (h16*)(R + R_Y);
    const unsigned long long* bm = (const unsigned long long*)(R + R_BM);
    const float* bd = (const float*)(p.ws + WS_BIASD) + 4 * 132;
    LAS h16* Ks0 = (LAS h16*)lds;
    LAS h16* Vt0 = (LAS h16*)(lds + 34816);
    LAS float* bdl = (LAS float*)(lds + 71680);
    const int hd = wave & 3, qs = wave >> 2, r = lane & 31, hh = lane >> 5;
    const int tb0 = b * SEQ; const int q0 = qb * 64 + 32 * qs;
    for (int i = tid; i < 4 * 132; i += NTHREADS) bdl[i] = bd[i];
    h16x8 qf[8];
#pragma unroll
    for (int s = 0; s < 8; ++s) qf[s] = *(const h16x8*)(proj + (size_t)(tb0 + q0 + r) * OD_N + 1536 + hd * 128 + 16 * s + 8 * hh);
    f32x16 o[4];
#pragma unroll
    for (int d = 0; d < 4; ++d)
#pragma unroll
        for (int i = 0; i < 16; ++i) o[d][i] = 0.f;
    float m_run = -INFINITY, l_run = 0.f;
    const int qp = q0 + r;
    const int vlo = r * 72 + ((hh ^ (r >> 3)) << 2), vhi = r * 72 + (((hh ^ (r >> 3)) ^ 2) << 2);
    const unsigned long long* bmq = bm + (size_t)(tb0 + qp) * 64;
    const LAS float* bdh = bdl + hd * 132;
    const int nkt = qb + 1;
    h16x8 pk[2], pv[2];
#pragma unroll
    for (int i = 0; i < 2; ++i) { const int key = i * 32 + (tid >> 4), ch = tid & 15;
        pk[i] = *(const h16x8*)(proj + (size_t)(tb0 + key) * OD_N + 2048 + ch * 8);
        pv[i] = *(const h16x8*)(proj + (size_t)(tb0 + key) * OD_N + 2176 + ch * 8); }
    ATT_STAGE(0, 2048, 2176, 1);
    unsigned long long mkn = bmq[0];
    __syncthreads();
    for (int kt = 0; kt < nkt; ++kt) {
        const int k0 = kt * 64; const int cur = kt & 1;
        const LAS h16* Ks = Ks0 + cur * 8704; const LAS h16* Vt = Vt0 + cur * 9216;
        const unsigned long long mk = mkn; mkn = bmq[kt + 1 < nkt ? kt + 1 : kt];
        if (kt + 1 < nkt) ATT_STAGE(cur ^ 1, 2048, 2176, kt + 2);
        if (__ballot(mk != 0ull) != 0ull) {
            const bool far = (k0 + 63 + 128 <= q0);
            const float bfar = bdh[128];
#pragma unroll
            for (int sub = 0; sub < 2; ++sub) {
                const unsigned mw = (unsigned)(mk >> (32 * sub));
                if (__ballot(mw != 0u) == 0ull) continue;
                f32x16 sc;
#pragma unroll
                for (int i = 0; i < 16; ++i) sc[i] = 0.f;
#pragma unroll
                for (int s = 0; s < 8; ++s) sc = mma32(*(const LAS h16x8*)(Ks + (32 * sub + r) * 136 + 16 * s + 8 * hh), qf[s], sc);
                float mx = -INFINITY;
#pragma unroll
                for (int i = 0; i < 16; ++i) { const int ko = (i & 3) + 8 * (i >> 2) + 4 * hh; const int dist = qp - (k0 + 32 * sub + ko);
                    float bias = bfar; if (!far) bias = bdh[dist < 0 ? 0 : (dist < 128 ? dist : 128)];
                    const float v = ((mw >> ko) & 1u) ? sc[i] + bias : -INFINITY; sc[i] = v; mx = fmaxf(mx, v); }
                mx = fmaxf(mx, __shfl_xor(mx, 32));
                const float m_new = fmaxf(m_run, mx);
                const float msafe = (m_new == -INFINITY) ? 0.f : m_new;
                const float alpha = __builtin_amdgcn_exp2f(m_run - msafe);
                const bool resc = __ballot(m_new > m_run) != 0ull;
                float ls = 0.f;
#pragma unroll
                for (int i = 0; i < 16; ++i) { const float e = __builtin_amdgcn_exp2f(sc[i] - msafe); sc[i] = e; ls += e; }
                ls += __shfl_xor(ls, 32);
                l_run = l_run * alpha + ls; m_run = m_new;
                if (resc) {
#pragma unroll
                    for (int d = 0; d < 4; ++d)
#pragma unroll
                        for (int i = 0; i < 16; ++i) o[d][i] *= alpha;
                }
#pragma unroll
                for (int s2 = 0; s2 < 2; ++s2) {
                    h16x8 pf;
#pragma unroll
                    for (int jj = 0; jj < 8; ++jj) pf[jj] = (h16)sc[8 * s2 + jj];
#pragma unroll
                    for (int d = 0; d < 4; ++d) {
                        const int coff = 32 * d * 72 + ((((sub << 1) | s2) ^ d) << 4);
                        const h16x4 lo = *(const LAS h16x4*)(Vt + vlo + coff), hi = *(const LAS h16x4*)(Vt + vhi + coff);
                        h16x8 vf; vf[0] = lo[0]; vf[1] = lo[1]; vf[2] = lo[2]; vf[3] = lo[3]; vf[4] = hi[0]; vf[5] = hi[1]; vf[6] = hi[2]; vf[7] = hi[3];
                        o[d] = mma32(vf, pf, o[d]);
                    }
                }
            }
        }
        __syncthreads();
    }
#undef ATT_STAGE
    const float inv = 1.f / l_run;
#pragma unroll
    for (int d = 0; d < 4; ++d)
#pragma unroll
        for (int i = 0; i < 16; ++i) { const int dv = 32 * d + (i & 3) + 8 * (i >> 2) + 4 * hh;
            y[(size_t)(tb0 + q0 + r) * D + 512 + hd * 128 + dv] = (h16)(o[d][i] * inv); }
}

__device__ __forceinline__ void phase_odd_attn(const int wid_s, CParams& p, int j, int layer, LAS unsigned char* lds) {
    int tid_ = TIDX; asm volatile("" : "+v"(tid_));
    const int tid = tid_, lane = tid & 63, wave = tid >> 6;
    for (int w = blockIdx.x; w < 256; w += gridDim.x) {
        const int xcd = w & 7, kx = w >> 3;
        {
#pragma unroll 1
            for (int i = 0; i < 4; ++i) { const int b = xcd + 8 * (i >> 1); const int qb = (i & 1) ? (63 - kx) : kx;
                dsa_select_item(p, lds, b, 2 * qb, tid, wave); dsa_select_item(p, lds, b, 2 * qb + 1, tid, wave);
                __syncthreads();
                dsa_attn_item(p, lds, b, qb, tid, wave);
                __syncthreads(); }
        }
        __syncthreads();
        {
#pragma unroll 1
            for (int i = 0; i < 8; ++i) { const int bh = xcd * 8 + i, b = bh >> 2, h = bh & 3; const int base = (kx + 8 * (i >> 1)) & 31; const int qb = (i & 1) ? (31 - base) : base;
                diff_attn_item(p, j, layer, lds, b, h, qb, tid, lane, wave); __syncthreads(); }
        }
    }
}

__device__ __forceinline__ void grid_barrier(unsigned* ctr, unsigned gen, const int wid_s) {
    __syncthreads();
    if (TIDX == 0) {
        __builtin_amdgcn_fence(__ATOMIC_RELEASE, "agent");
        asm volatile("s_waitcnt vmcnt(0)" ::: "memory");
        const unsigned target = gen * gridDim.x;
        __hip_atomic_fetch_add(ctr, 1u, __ATOMIC_RELAXED, __HIP_MEMORY_SCOPE_AGENT);
        unsigned spins = 0;
        while (__hip_atomic_load(ctr, __ATOMIC_RELAXED, __HIP_MEMORY_SCOPE_AGENT) < target) { __builtin_amdgcn_s_sleep(1); if (++spins > (1u << 24)) break; }
        __builtin_amdgcn_fence(__ATOMIC_ACQUIRE, "agent");
        asm volatile("s_waitcnt vmcnt(0)" ::: "memory");
    }
    __syncthreads();
}

__global__ void __launch_bounds__(NTHREADS, 2) mk_fwd(Params p_unused) {
    extern __shared__ __attribute__((aligned(16))) unsigned char lds_raw[];
    LAS unsigned char* lds = (LAS unsigned char*)lds_raw;
    cg::grid_group grid = cg::this_grid();
    const int wid_s = __builtin_amdgcn_readfirstlane((int)(threadIdx.x >> 6));
    int ph = 0;
    const int ph_lo = launder_kp()->ph_lo, ph_hi = launder_kp()->ph_hi;
#define PHASE_BEGIN if (ph >= ph_lo && ph < ph_hi) { CParams& p = *launder_kp(); unsigned char* ws = p.ws; h16* hb = (h16*)(ws + WS_HB); float* rsq = (float*)(ws + WS_RSQ); unsigned char* R = ws + WS_R; (void)hb; (void)rsq; (void)R;
#define PHASE_END   if (ph + 1 < ph_hi) { if (ph == 0) grid.sync(); else grid_barrier((unsigned*)(launder_kp()->ws + WS_MISC + 128), (unsigned)ph, wid_s); } } ++ph;

    PHASE_BEGIN phase_prep(wid_s, p, lds); PHASE_END

    for (int l = 0; l < DEPTH; ++l) {
        const int j = l >> 1;
        if ((l & 1) == 0) {
            PHASE_BEGIN {
                pg8::Gemm g{hb, (const h16*)(ws + WS_WIN_E + j * SZ_WIN_E), T, EV_N, D, D}; pg8::StaticOrder S; S.init(T, EV_N, gridDim.x, blockIdx.x);
                pg8::EpiStoreH E{(h16*)(R + R_PROJ), EV_N, rsq + (size_t)(2 * l) * T, 4, 12, (float*)(ws + WS_BA), nullptr};
                pg8::gemm_phase<pg8::EpiStoreH>(lds, g, S, E, wid_s);
            } PHASE_END
            PHASE_BEGIN phase_even_mix(wid_s, p, j, lds); PHASE_END
            PHASE_BEGIN phase_gdn_scan(wid_s, p, lds); PHASE_END
            PHASE_BEGIN phase_gdn_gate(wid_s, p, j); PHASE_END
            PHASE_BEGIN {
                pg8::Gemm g{(const h16*)(R + R_Y), (const h16*)(ws + WS_WOUT + l * SZ_WOUT), T, D, D, D}; pg8::StaticOrder S; S.init(T, D, gridDim.x, blockIdx.x);
                pg8::EpiResid E{hb, rsq + (size_t)(2 * l + 1) * T, nullptr};
                pg8::gemm_phase<pg8::EpiResid>(lds, g, S, E, wid_s);
            } PHASE_END
        } else {
            PHASE_BEGIN {
                pg8::Gemm g{hb, (const h16*)(ws + WS_WIN_O + j * SZ_WIN_O), T, OD_N, D, D}; pg8::StaticOrder S; S.init(T, OD_N, gridDim.x, blockIdx.x);
                pg8::EpiOddIn E{(h16*)(R + R_PROJ), OD_N, rsq + (size_t)(2 * l) * T, (const float*)(ws + WS_GTAB) + j * 512, (LAS float*)(lds + 131072)};
                pg8::gemm_phase<pg8::EpiOddIn>(lds, g, S, E, wid_s);
            } PHASE_END
            PHASE_BEGIN phase_odd_attn(wid_s, p, j, l, lds); PHASE_END
            PHASE_BEGIN {
                pg8::Gemm g{(const h16*)(R + R_Y), (const h16*)(ws + WS_WOUT + l * SZ_WOUT), T, D, D, D}; pg8::StaticOrder S; S.init(T, D, gridDim.x, blockIdx.x);
                pg8::EpiResid E{hb, rsq + (size_t)(2 * l + 1) * T, nullptr};
                pg8::gemm_phase<pg8::EpiResid>(lds, g, S, E, wid_s);
            } PHASE_END
        }
        PHASE_BEGIN {
            pg8::Gemm g{hb, (const h16*)(ws + WS_WUP + l * SZ_WUP), T, FF2, D, D}; pg8::StaticOrder S; S.init(T, FF2, gridDim.x, blockIdx.x);
            pg8::EpiUpFused E{(h16*)R, rsq + (size_t)(2 * l + 1) * T, p.in[21] + (size_t)l * 3 * FF2, p.in[22] + (size_t)l * FF2, (h16*)(ws + WS_HALO), (LAS float*)(lds + 131072)};
            pg8::gemm_phase<pg8::EpiUpFused>(lds, g, S, E, wid_s);
        } PHASE_END
        PHASE_BEGIN phase_ffn_fixup(wid_s, (h16*)R, (const h16*)(ws + WS_HALO), p.in[21] + (size_t)l * 3 * FF2, p.in[22] + (size_t)l * FF2); PHASE_END
        PHASE_BEGIN {
            pg8::Gemm g{(const h16*)R, (const h16*)(ws + WS_WDN + l * SZ_WDN), T, D, FF, FF}; pg8::StaticOrder S; S.init(T, D, gridDim.x, blockIdx.x);
            pg8::EpiResid E{hb, rsq + (size_t)(2 * l + 2) * T, (l == DEPTH - 1) ? p.out : nullptr};
            pg8::gemm_phase<pg8::EpiResid>(lds, g, S, E, wid_s);
        } PHASE_END
    }
}

extern "C" void kernel_launch(void* const* d_in, const int* in_sizes, int n_in, void* d_out, int out_size, void* d_ws, size_t ws_size, hipStream_t stream) {
    static int grid_blocks = 0;
    if (grid_blocks == 0) {
        if (ws_size < WS_END) { fprintf(stderr, "kernel_launch: workspace too small: %zu < %zu\n", ws_size, (size_t)WS_END); grid_blocks = -1; return; }
        int dev = 0, cus = 0, per_cu = 0;
        hipGetDevice(&dev);
        hipDeviceGetAttribute(&cus, hipDeviceAttributeMultiprocessorCount, dev);
        if (hipFuncSetAttribute((const void*)mk_fwd, hipFuncAttributeMaxDynamicSharedMemorySize, LDS_BYTES) != hipSuccess) { fprintf(stderr, "kernel_launch: hipFuncSetAttribute failed\n"); grid_blocks = -1; return; }
        hipOccupancyMaxActiveBlocksPerMultiprocessor(&per_cu, (const void*)mk_fwd, NTHREADS, LDS_BYTES);
        if (per_cu < 1) per_cu = 1;
        grid_blocks = cus * 1;
        fprintf(stderr, "kernel_launch: cus %d per_cu %d grid %d ws %zu need %zu\n", cus, per_cu, grid_blocks, ws_size, (size_t)WS_END);
    }
    if (grid_blocks < 0) return;
    if (hipMemsetAsync((char*)d_ws + WS_MISC + 128, 0, 64, stream) != hipSuccess) { fprintf(stderr, "kernel_launch: memset failed\n"); return; }
    Params p{};
    for (int i = 0; i < 24; ++i) p.in[i] = (const float*)d_in[i];
    p.out = (float*)d_out; p.ws = (unsigned char*)d_ws; p.ph_lo = 0; p.ph_hi = 1000;
    void* args[] = {&p};
    hipError_t e = hipLaunchCooperativeKernel((const void*)mk_fwd, dim3(grid_blocks), dim3(NTHREADS), args, LDS_BYTES, stream);
    if (e != hipSuccess) fprintf(stderr, "cooperative launch failed: %s (grid %d)\n", hipGetErrorString(e), grid_blocks);
}
```
